# Optimizing an MI355X kernel written in HIP

```python
import jax
import jax.numpy as jnp
from jax import lax
import numpy as np

D_MODEL = 1024
BATCH = 4
SEQ = 8192
DEPTH = 4

MEM_LEN = 256
EPS = 1e-6
F32 = jnp.float32

GLA_HEADS = 6
GLA_DK = 32
GLA_DV = 64
GLA_RANK = 16
GLA_TAU = 16.0
GLA_CHUNK = 64

RET_HEADS = 6
RET_DK = 32
RET_DV = 64
RET_CHUNK = 128
ROPE_BASE = 10000.0

ML_HEADS = 4
ML_DK = 64
ML_DV = 64
ML_CHUNK = 64
ML_CONV = 4
ML_FBIAS_LO = 3.0
ML_FBIAS_HI = 6.0

D_MIX = GLA_HEADS * GLA_DV + RET_HEADS * RET_DV + ML_HEADS * ML_DV
IN_SIZES = (
    GLA_HEADS * GLA_DK, GLA_HEADS * GLA_DK, GLA_HEADS * GLA_DV, GLA_RANK, GLA_HEADS * GLA_DV,
    RET_HEADS * RET_DK, RET_HEADS * RET_DK, RET_HEADS * RET_DV, RET_HEADS * RET_DV,
    ML_HEADS * ML_DK, ML_HEADS * ML_DK, ML_HEADS * ML_DV, ML_HEADS * ML_DV, ML_HEADS, ML_HEADS,
)
D_IN = sum(IN_SIZES)

XA_HEADS = 4
XA_DH = D_MODEL // XA_HEADS
D_FF = ((8 * D_MODEL // 3 + 127) // 128) * 128
MAX_POS_OFFSET = 1024

kernel_name = "hybrid_gla_retnet_mlstm_macaron"


def rmsnorm(x, g):
    xf = x.astype(F32)
    y = xf * lax.rsqrt(jnp.mean(xf * xf, axis=-1, keepdims=True) + EPS)
    return (y * g.astype(F32)).astype(x.dtype)


def head_rmsnorm(x, g):
    b, s, h, d = x.shape
    xf = x.astype(F32)
    y = xf * lax.rsqrt(jnp.mean(xf * xf, axis=-1, keepdims=True) + EPS)
    return y.reshape(b, s, h * d) * g.astype(F32)


def head_groupnorm(x, g):
    b, s, h, d = x.shape
    xf = x.astype(F32)
    mu = jnp.mean(xf, axis=-1, keepdims=True)
    xc = xf - mu
    y = xc * lax.rsqrt(jnp.mean(xc * xc, axis=-1, keepdims=True) + EPS)
    return y.reshape(b, s, h * d) * g.astype(F32)


def swiglu_ffn(x, w_gu, w_down):
    a, g = jnp.split(x @ w_gu, 2, axis=-1)
    return (jax.nn.silu(a) * g) @ w_down


def _to_chunks(t, c):
    b, s, h, d = t.shape
    return t.reshape(b, s // c, c, h, d).transpose(1, 0, 3, 2, 4)


def _from_chunks(t):
    n, b, h, c, d = t.shape
    return t.transpose(1, 0, 3, 2, 4).reshape(b, n * c, h, d)


def rotary(x, positions):
    half = x.shape[-1] // 2
    inv_freq = 1.0 / (ROPE_BASE ** jnp.linspace(0.0, 1.0, half, dtype=F32))
    ang = positions.astype(F32)[..., None] * inv_freq
    cos = jnp.cos(ang)[:, :, None, :]
    sin = jnp.sin(ang)[:, :, None, :]
    x1 = x[..., :half].astype(F32)
    x2 = x[..., half:].astype(F32)
    return jnp.concatenate([x1 * cos - x2 * sin, x1 * sin + x2 * cos], axis=-1).astype(x.dtype)


def causal_dwconv(x, w):
    k = w.shape[0]
    return lax.conv_general_dilated(
        x, w[:, None, :].astype(x.dtype), window_strides=(1,), padding=[(k - 1, 0)],
        dimension_numbers=("NWC", "WIO", "NWC"), feature_group_count=x.shape[-1])


def gla_chunked(q, k, v, log_a):
    b, s, h, dk = q.shape
    dv = v.shape[-1]
    c = GLA_CHUNK
    qc = _to_chunks(q * dk ** -0.5, c)
    kc = _to_chunks(k, c)
    vc = _to_chunks(v, c)
    ac = _to_chunks(log_a.astype(F32), c)
    causal = jnp.tril(jnp.ones((c, c), bool))[:, :, None]

    def step(state, inp):
        qi, ki, vi, ai = inp
        bcum = jnp.cumsum(ai, axis=2)
        b_last = bcum[:, :, -1:, :]
        diff = bcum[:, :, :, None, :] - bcum[:, :, None, :, :]
        decay = jnp.exp(jnp.where(causal, diff, -jnp.inf))
        scores = jnp.einsum("bhid,bhjd,bhijd->bhij", qi, ki, decay)
        o = (jnp.einsum("bhij,bhjv->bhiv", scores, vi)
             + jnp.einsum("bhid,bhdv->bhiv", qi * jnp.exp(bcum), state))
        state = (jnp.exp(b_last)[:, :, 0, :, None] * state
                 + jnp.einsum("bhjd,bhjv->bhdv", ki * jnp.exp(b_last - bcum), vi))
        return state, o

    s0 = jnp.zeros((b, h, dk, dv), F32)
    _, out = lax.scan(step, s0, (qc, kc, vc, ac))
    return _from_chunks(out)


def retention_chunked(q, k, v):
    b, s, h, dk = q.shape
    dv = v.shape[-1]
    c = RET_CHUNK
    log_g = jnp.log(1.0 - 2.0 ** (-5.0 - jnp.arange(h, dtype=F32)))
    idx = jnp.arange(c, dtype=F32)
    rel = idx[:, None] - idx[None, :]
    decay = jnp.where(rel >= 0, jnp.exp(log_g[:, None, None] * jnp.maximum(rel, 0.0)), 0.0)
    q_dec = jnp.exp(log_g[:, None] * (idx + 1.0))[:, :, None]
    k_dec = jnp.exp(log_g[:, None] * (c - 1.0 - idx))[:, :, None]
    chunk_dec = jnp.exp(log_g * c)[:, None, None]
    qc = _to_chunks(q, c)
    kc = _to_chunks(k * dk ** -0.5, c)
    vc = _to_chunks(v, c)

    def step(r, inp):
        qi, ki, vi = inp
        scores = jnp.einsum("bhid,bhjd->bhij", qi, ki) * decay
        o = jnp.einsum("bhij,bhjv->bhiv", scores, vi) + q_dec * jnp.einsum("bhid,bhdv->bhiv", qi, r)
        r = chunk_dec * r + jnp.einsum("bhjd,bhjv->bhdv", ki * k_dec, vi)
        return r, o

    r0 = jnp.zeros((b, h, dk, dv), F32)
    _, out = lax.scan(step, r0, (qc, kc, vc))
    return _from_chunks(out)


def mlstm_chunked(q, k, v, i_pre, f_pre):
    b, s, h, dk = q.shape
    dv = v.shape[-1]
    c = ML_CHUNK
    qc = _to_chunks(q, c)
    kc = _to_chunks(k * dk ** -0.5, c)
    vc = _to_chunks(v, c)
    ic = _to_chunks(i_pre.astype(F32)[..., None], c)[..., 0]
    fc = _to_chunks(jax.nn.log_sigmoid(f_pre.astype(F32))[..., None], c)[..., 0]
    causal = jnp.tril(jnp.ones((c, c), bool))

    def step(carry, inp):
        c_st, n_st, m_st = carry
        qi, ki, vi, ii, lfi = inp
        bcum = jnp.cumsum(lfi, axis=-1)
        d_log = jnp.where(causal, bcum[..., :, None] - bcum[..., None, :] + ii[..., None, :], -jnp.inf)
        inter_log = bcum + m_st[..., None]
        m_t = jnp.maximum(inter_log, jnp.max(d_log, axis=-1))
        w_inter = jnp.exp(inter_log - m_t)
        s_qk = jnp.einsum("bhid,bhjd->bhij", qi, ki) * jnp.exp(d_log - m_t[..., None])
        num = (jnp.einsum("bhij,bhjv->bhiv", s_qk, vi)
               + w_inter[..., None] * jnp.einsum("bhid,bhdv->bhiv", qi, c_st))
        den = jnp.sum(s_qk, axis=-1) + w_inter * jnp.einsum("bhid,bhd->bhi", qi, n_st)
        h_t = num / jnp.maximum(jnp.abs(den), jnp.exp(-m_t))[..., None]
        b_last = bcum[..., -1]
        log_w = b_last[..., None] - bcum + ii
        m_new = jnp.maximum(b_last + m_st, jnp.max(log_w, axis=-1))
        g_prev = jnp.exp(b_last + m_st - m_new)
        wk = jnp.exp(log_w - m_new[..., None])[..., None] * ki
        c_new = g_prev[..., None, None] * c_st + jnp.einsum("bhjd,bhjv->bhdv", wk, vi)
        n_new = g_prev[..., None] * n_st + jnp.sum(wk, axis=2)
        return (c_new, n_new, m_new), h_t

    carry0 = (jnp.zeros((b, h, dk, dv), F32), jnp.zeros((b, h, dk), F32), jnp.zeros((b, h), F32))
    _, out = lax.scan(step, carry0, (qc, kc, vc, ic, fc))
    return _from_chunks(out)


def hybrid_mix(hn, positions, w_in, gla_w_a2, gla_b_a, gla_g_norm, ret_g_norm,
               ml_conv, ml_b_i, ml_b_f, w_out):
    b, s, _ = hn.shape
    split_points = np.cumsum(IN_SIZES)[:-1].tolist()
    (gq, gk, gv, ga, gr, rq, rk, rv, rg, mq, mk, mv, mo, mi, mf) = jnp.split(hn @ w_in, split_points, axis=-1)

    def heads(t, nh):
        return t.reshape(b, s, nh, -1)

    log_a = jax.nn.log_sigmoid((ga @ gla_w_a2 + gla_b_a).astype(F32)) / GLA_TAU
    o_gla = gla_chunked(heads(gq, GLA_HEADS), heads(gk, GLA_HEADS), heads(gv, GLA_HEADS), heads(log_a, GLA_HEADS))
    o_gla = (head_rmsnorm(o_gla, gla_g_norm) * jax.nn.silu(gr.astype(F32))).astype(hn.dtype)

    rq = rotary(heads(rq, RET_HEADS), positions)
    rk = rotary(heads(rk, RET_HEADS), positions)
    o_ret = retention_chunked(rq, rk, heads(rv, RET_HEADS))
    o_ret = (head_groupnorm(o_ret, ret_g_norm) * jax.nn.silu(rg.astype(F32))).astype(hn.dtype)

    mqk = jax.nn.silu(causal_dwconv(jnp.concatenate([mq, mk], axis=-1), ml_conv))
    mq, mk = jnp.split(mqk, 2, axis=-1)
    o_ml = mlstm_chunked(heads(mq, ML_HEADS), heads(mk, ML_HEADS), heads(mv, ML_HEADS), mi + ml_b_i, mf + ml_b_f)
    o_ml = (jax.nn.sigmoid(mo.astype(F32)) * o_ml.reshape(b, s, -1)).astype(hn.dtype)

    return jnp.concatenate([o_gla, o_ret, o_ml], axis=-1) @ w_out


def mem_cross_attn(hn, memn, w_q, w_kv, w_o):
    b, s, d = hn.shape
    m = memn.shape[1]
    q = (hn @ w_q).reshape(b, s, XA_HEADS, XA_DH)
    k, v = jnp.split(memn @ w_kv, 2, axis=-1)
    k = k.reshape(b, m, XA_HEADS, XA_DH)
    v = v.reshape(b, m, XA_HEADS, XA_DH)
    scores = jnp.einsum("bshd,bmhd->bhsm", q, k).astype(F32) * XA_DH ** -0.5
    p = jax.nn.softmax(scores, axis=-1).astype(v.dtype)
    o = jnp.einsum("bhsm,bmhd->bshd", p, v).reshape(b, s, d)
    return o @ w_o


def setup_inputs(seed: int = 0) -> dict:
    key = jax.random.key(seed)
    ks = jax.random.split(key, 32)
    L, D = DEPTH, D_MODEL

    def w(k, shape, fan_in):
        return jax.random.normal(k, shape, F32) * fan_in ** -0.5

    def gain(k, shape):
        return 1.0 + 0.02 * jax.random.normal(k, shape, F32)

    x = jax.random.normal(ks[0], (BATCH, SEQ, D), F32)
    mem = jax.random.normal(ks[1], (BATCH, MEM_LEN, D), F32)
    positions = (jnp.arange(SEQ, dtype=jnp.int32)[None, :]
                 + jax.random.randint(ks[2], (BATCH, 1), 0, MAX_POS_OFFSET, dtype=jnp.int32))
    ml_b_f = (jnp.linspace(ML_FBIAS_LO, ML_FBIAS_HI, ML_HEADS, dtype=F32)[None, :]
              + 0.1 * jax.random.normal(ks[14], (L, ML_HEADS), F32))
    return {
        "x": x,
        "mem": mem,
        "positions": positions,
        "g_ffa": gain(ks[3], (L, D)),
        "w_ffa_gu": w(ks[4], (L, D, 2 * D_FF), D),
        "w_ffa_down": w(ks[5], (L, D_FF, D), D_FF),
        "g_mix": gain(ks[6], (L, D)),
        "w_in": w(ks[7], (L, D, D_IN), D),
        "gla_w_a2": w(ks[8], (L, GLA_RANK, GLA_HEADS * GLA_DK), GLA_RANK),
        "gla_b_a": 0.1 * jax.random.normal(ks[9], (L, GLA_HEADS * GLA_DK), F32),
        "gla_g_norm": gain(ks[10], (L, GLA_HEADS * GLA_DV)),
        "ret_g_norm": gain(ks[11], (L, RET_HEADS * RET_DV)),
        "ml_conv": w(ks[12], (L, ML_CONV, 2 * ML_HEADS * ML_DK), ML_CONV),
        "ml_b_i": 0.1 * jax.random.normal(ks[13], (L, ML_HEADS), F32),
        "ml_b_f": ml_b_f,
        "w_out": w(ks[15], (L, D_MIX, D), D_MIX),
        "g_xa": gain(ks[16], (L, D)),
        "g_mem": gain(ks[17], (L, D)),
        "w_xa_q": w(ks[18], (L, D, D), D),
        "w_xa_kv": w(ks[19], (L, D, 2 * D), D),
        "w_xa_o": w(ks[20], (L, D, D), D),
        "g_ffb": gain(ks[21], (L, D)),
        "w_ffb_gu": w(ks[22], (L, D, 2 * D_FF), D),
        "w_ffb_down": w(ks[23], (L, D_FF, D), D_FF),
        "g_final": gain(ks[24], (D,)),
    }


def reference(x, mem, positions, g_ffa, w_ffa_gu, w_ffa_down, g_mix, w_in, gla_w_a2, gla_b_a,
              gla_g_norm, ret_g_norm, ml_conv, ml_b_i, ml_b_f, w_out, g_xa, g_mem, w_xa_q,
              w_xa_kv, w_xa_o, g_ffb, w_ffb_gu, w_ffb_down, g_final):
    for l in range(DEPTH):
        x = x + 0.5 * swiglu_ffn(rmsnorm(x, g_ffa[l]), w_ffa_gu[l], w_ffa_down[l])
        x = x + hybrid_mix(rmsnorm(x, g_mix[l]), positions, w_in[l], gla_w_a2[l], gla_b_a[l],
                           gla_g_norm[l], ret_g_norm[l], ml_conv[l], ml_b_i[l], ml_b_f[l], w_out[l])
        x = x + mem_cross_attn(rmsnorm(x, g_xa[l]), rmsnorm(mem, g_mem[l]), w_xa_q[l], w_xa_kv[l], w_xa_o[l])
        x = x + 0.5 * swiglu_ffn(rmsnorm(x, g_ffb[l]), w_ffb_gu[l], w_ffb_down[l])
    return rmsnorm(x, g_final)
```

```cpp
#include <hip/hip_runtime.h>
#include <cstdio>
#include <cstdint>

typedef unsigned short bf16;
typedef short bf16x8 __attribute__((ext_vector_type(8)));
typedef float f32x4 __attribute__((ext_vector_type(4)));

constexpr int BATCH = 4, SEQ = 8192, D = 1024, DEPTH = 4, MEMLEN = 256;
constexpr int M = BATCH * SEQ;
constexpr int DFF = 2816, DIN = 3352, DINP = 3584;
constexpr float EPS = 1e-6f;
constexpr int C_GQ = 0, C_GK = 192, C_GV = 384, C_GA = 768, C_GR = 784, C_RQ = 1168, C_RK = 1360, C_RV = 1552, C_RG = 1936,
              C_MQ = 2320, C_MK = 2576, C_MV = 2832, C_MO = 3088, C_MI = 3344, C_MF = 3348;

constexpr size_t MiB = 1u << 20;
constexpr size_t WS_CTL = 0, WS_ROPE = 1 * MiB, WS_PART = 5 * MiB, WS_MEMB = 7 * MiB, WS_MEMSS = 9 * MiB, WS_KB = 10 * MiB, WS_VT = 18 * MiB,
                 WS_WKV = 26 * MiB, WS_WL = 42 * MiB, WS_XB = 88 * MiB, WS_R = 152 * MiB,
                 WS_P = WS_R, WS_ST = 376 * MiB, WS_Y = 412 * MiB, WS_H = WS_R, WS_Q = WS_R, WS_O = 216 * MiB, WS_END = 476 * MiB;

__device__ __forceinline__ float bf2f(bf16 b) { return __uint_as_float(((unsigned)b) << 16); }
__device__ __forceinline__ bf16 f2bf(float f) { unsigned u = __float_as_uint(f); return (bf16)((u + 0x7fffu + ((u >> 16) & 1u)) >> 16); }
__device__ __forceinline__ float sigmoidf_(float x) { return 1.f / (1.f + __expf(-x)); }
__device__ __forceinline__ float siluf_(float x) { return x / (1.f + __expf(-x)); }
__device__ __forceinline__ float logsigf_(float x) { return fminf(x, 0.f) - __logf(1.f + __expf(-fabsf(x))); }
__device__ __forceinline__ float wave_sum(float v) {
#pragma unroll
    for (int o = 1; o < 64; o <<= 1) v += __shfl_xor(v, o);
    return v;
}
__device__ __forceinline__ float wave_max(float v) {
#pragma unroll
    for (int o = 1; o < 64; o <<= 1) v = fmaxf(v, __shfl_xor(v, o));
    return v;
}
__device__ __forceinline__ float row_rstd(const float* part, int row) {
    const f32x4* p = (const f32x4*)(part + (size_t)row * 16);
    f32x4 a = p[0], b = p[1], c = p[2], d = p[3];
    float s = ((a.x + a.y) + (a.z + a.w)) + ((b.x + b.y) + (b.z + b.w)) + ((c.x + c.y) + (c.z + c.w)) + ((d.x + d.y) + (d.z + d.w));
    return rsqrtf(s * (1.f / D) + EPS);
}

__global__ __launch_bounds__(256) void v0_stats(const float* x, bf16* xb, float* part, int rows) {
    const int lane = threadIdx.x & 63, row = blockIdx.x * 4 + (threadIdx.x >> 6);
    if (row >= rows) return;
    const f32x4* xr = (const f32x4*)(x + (size_t)row * D);
    float s = 0.f;
#pragma unroll
    for (int j = 0; j < 4; ++j) { f32x4 v = xr[lane + 64 * j]; s += (v.x * v.x + v.y * v.y) + (v.z * v.z + v.w * v.w);
        ushort4 o; o.x = f2bf(v.x); o.y = f2bf(v.y); o.z = f2bf(v.z); o.w = f2bf(v.w);
        *(ushort4*)(xb + (size_t)row * D + (lane + 64 * j) * 4) = o; }
    s = wave_sum(s);
    if (lane < 16) part[(size_t)row * 16 + lane] = (lane == 0) ? s : 0.f;
}
__global__ void v0_rope(const int* pos, float2* cs) {
    const int i = blockIdx.x * blockDim.x + threadIdx.x; if (i >= M * 16) return;
    const int r = i >> 4, m = i & 15;
    const float e = (float)m / 15.0f;
    const float invf = 1.0f / powf(10000.0f, e);
    const float ang = (float)pos[r] * invf;
    cs[i] = make_float2((float)cos((double)ang), (float)sin((double)ang));
}

struct EpiSwiglu { const float* part; bf16* h;
    __device__ void operator()(int m, int n, float a, float g) const { const float r = row_rstd(part, m); a *= r; g *= r; h[(size_t)m * DFF + n] = f2bf(siluf_(a) * g); } };
struct EpiRes { const float* xin; float* xout; float alpha;
    __device__ void operator()(int m, int n, float a, float) const { const size_t i = (size_t)m * D + n; xout[i] = xin[i] + alpha * a; } };
struct EpiScale { const float* part; bf16* out; int ldc; float scale;
    __device__ void operator()(int m, int n, float a, float) const { out[(size_t)m * ldc + n] = f2bf(a * row_rstd(part, m) * scale); } };
struct EpiKV { const float* mp; bf16* kb; bf16* vt;
    __device__ void operator()(int m, int n, float a, float) const { const float r = rsqrtf(mp[(size_t)m * 16] * (1.f / D) + EPS); a *= r;
        if (n < 1024) kb[(size_t)m * 1024 + n] = f2bf(a); else vt[((size_t)(m >> 8) * 1024 + (n - 1024)) * 256 + (m & 255)] = f2bf(a); } };

template <class Epi, bool DUAL>
__global__ __launch_bounds__(256) void v0_gemm(const bf16* A, int K, const float* W, int ldw, int nvalid, int dual_off, const float* gk, Epi E) {
    __shared__ __attribute__((aligned(16))) bf16 As[128][40];
    __shared__ __attribute__((aligned(16))) bf16 Bs[DUAL ? 2 : 1][128][40];
    const int tid = threadIdx.x, lane = tid & 63, wid = tid >> 6, wr = wid >> 1, wc = wid & 1;
    const int m0 = blockIdx.y * 128, n0 = blockIdx.x * 128;
    f32x4 acc[DUAL ? 2 : 1][4][4];
#pragma unroll
    for (int d = 0; d < (DUAL ? 2 : 1); ++d)
#pragma unroll
        for (int i = 0; i < 4; ++i)
#pragma unroll
            for (int j = 0; j < 4; ++j) acc[d][i][j] = (f32x4){0.f, 0.f, 0.f, 0.f};
    for (int k0 = 0; k0 < K; k0 += 32) {
        { const int row = tid >> 1, ko = (tid & 1) * 16;
          const uint4* src = (const uint4*)(A + (size_t)(m0 + row) * K + k0 + ko);
          const uint4 v0 = src[0], v1 = src[1];
          *(uint4*)&As[row][ko] = v0; *(uint4*)&As[row][ko + 8] = v1; }
        { const int k = tid >> 3, nc = (tid & 7) * 16; const float g = gk ? gk[k0 + k] : 1.f;
#pragma unroll
          for (int d = 0; d < (DUAL ? 2 : 1); ++d)
#pragma unroll
              for (int j = 0; j < 16; ++j) { const int n = n0 + nc + j;
                  const float w = (n < nvalid) ? W[(size_t)(k0 + k) * ldw + n + d * dual_off] * g : 0.f; Bs[d][nc + j][k] = f2bf(w); } }
        __syncthreads();
        bf16x8 a[4];
#pragma unroll
        for (int mt = 0; mt < 4; ++mt) a[mt] = *(const bf16x8*)&As[wr * 64 + mt * 16 + (lane & 15)][(lane >> 4) * 8];
#pragma unroll
        for (int d = 0; d < (DUAL ? 2 : 1); ++d)
#pragma unroll
            for (int nt = 0; nt < 4; ++nt) { const bf16x8 b = *(const bf16x8*)&Bs[d][wc * 64 + nt * 16 + (lane & 15)][(lane >> 4) * 8];
#pragma unroll
                for (int mt = 0; mt < 4; ++mt) acc[d][mt][nt] = __builtin_amdgcn_mfma_f32_16x16x32_bf16(a[mt], b, acc[d][mt][nt], 0, 0, 0); }
        __syncthreads();
    }
#pragma unroll
    for (int mt = 0; mt < 4; ++mt)
#pragma unroll
        for (int nt = 0; nt < 4; ++nt)
#pragma unroll
            for (int r = 0; r < 4; ++r) { const int m = m0 + wr * 64 + mt * 16 + (lane >> 4) * 4 + r, n = n0 + wc * 64 + nt * 16 + (lane & 15);
                if (n < nvalid) E(m, n, acc[0][mt][nt][r], DUAL ? acc[DUAL ? 1 : 0][mt][nt][r] : 0.f); }
}

__global__ __launch_bounds__(64) void v0_gla(const bf16* P, const float* w_a2, const float* b_a, const float* g_norm, bf16* Y) {
    __shared__ float qs[64][32], ks[64][32], as[64][32], vs[64][64], os[64][65];
    const int b = blockIdx.x / 6, h = blockIdx.x % 6, lane = threadIdx.x;
    float S[32];
#pragma unroll
    for (int d = 0; d < 32; ++d) S[d] = 0.f;
    for (int ch = 0; ch < SEQ / 64; ++ch) {
        const size_t row = (size_t)b * SEQ + ch * 64 + lane; const bf16* p = P + row * DINP;
        float ga[16];
#pragma unroll
        for (int r = 0; r < 16; ++r) ga[r] = bf2f(p[C_GA + r]);
        for (int c = 0; c < 32; ++c) { float z = b_a[h * 32 + c];
#pragma unroll
            for (int r = 0; r < 16; ++r) z += ga[r] * w_a2[r * 192 + h * 32 + c];
            as[lane][c] = __expf(logsigf_(z) * (1.f / 16.f));
            qs[lane][c] = bf2f(p[C_GQ + h * 32 + c]) * 0.17677669529663687f; ks[lane][c] = bf2f(p[C_GK + h * 32 + c]); }
        for (int c = 0; c < 64; ++c) vs[lane][c] = bf2f(p[C_GV + h * 64 + c]);
        __syncthreads();
        for (int t = 0; t < 64; ++t) { const float v = vs[t][lane]; float o = 0.f;
#pragma unroll
            for (int d = 0; d < 32; ++d) { S[d] = as[t][d] * S[d] + ks[t][d] * v; o += qs[t][d] * S[d]; }
            os[t][lane] = o; }
        __syncthreads();
        float ss = 0.f;
        for (int c = 0; c < 64; ++c) ss += os[lane][c] * os[lane][c];
        const float rn = rsqrtf(ss * (1.f / 64.f) + EPS);
        for (int c = 0; c < 64; ++c) { const float g = bf2f(p[C_GR + h * 64 + c]);
            Y[row * D + h * 64 + c] = f2bf(os[lane][c] * rn * g_norm[h * 64 + c] * siluf_(g)); }
        __syncthreads();
    }
}
__global__ __launch_bounds__(64) void v0_ret(const bf16* P, const float2* cs, const float* g_norm, bf16* Y) {
    __shared__ float qs[64][32], ks[64][32], vs[64][64], os[64][65];
    const int b = blockIdx.x / 6, h = blockIdx.x % 6, lane = threadIdx.x;
    const float gamma = 1.f - exp2f(-5.f - (float)h);
    float S[32];
#pragma unroll
    for (int d = 0; d < 32; ++d) S[d] = 0.f;
    for (int ch = 0; ch < SEQ / 64; ++ch) {
        const size_t row = (size_t)b * SEQ + ch * 64 + lane; const bf16* p = P + row * DINP;
        for (int m = 0; m < 16; ++m) { const float2 c = cs[row * 16 + m];
            const float q1 = bf2f(p[C_RQ + h * 32 + m]), q2 = bf2f(p[C_RQ + h * 32 + 16 + m]);
            const float k1 = bf2f(p[C_RK + h * 32 + m]), k2 = bf2f(p[C_RK + h * 32 + 16 + m]);
            qs[lane][m] = q1 * c.x - q2 * c.y; qs[lane][m + 16] = q1 * c.y + q2 * c.x;
            ks[lane][m] = (k1 * c.x - k2 * c.y) * 0.17677669529663687f; ks[lane][m + 16] = (k1 * c.y + k2 * c.x) * 0.17677669529663687f; }
        for (int c = 0; c < 64; ++c) vs[lane][c] = bf2f(p[C_RV + h * 64 + c]);
        __syncthreads();
        for (int t = 0; t < 64; ++t) { const float v = vs[t][lane]; float o = 0.f;
#pragma unroll
            for (int d = 0; d < 32; ++d) { S[d] = gamma * S[d] + ks[t][d] * v; o += qs[t][d] * S[d]; }
            os[t][lane] = o; }
        __syncthreads();
        float mu = 0.f;
        for (int c = 0; c < 64; ++c) mu += os[lane][c];
        mu *= (1.f / 64.f);
        float var = 0.f;
        for (int c = 0; c < 64; ++c) { const float d = os[lane][c] - mu; var += d * d; }
        const float rn = rsqrtf(var * (1.f / 64.f) + EPS);
        for (int c = 0; c < 64; ++c) { const float g = bf2f(p[C_RG + h * 64 + c]);
            Y[row * D + 384 + h * 64 + c] = f2bf((os[lane][c] - mu) * rn * g_norm[h * 64 + c] * siluf_(g)); }
        __syncthreads();
    }
}
__global__ __launch_bounds__(64) void v0_mlstm(const bf16* P, const float* conv  , const float* b_i, const float* b_f, bf16* Y) {
    __shared__ float qs[64][64], ks[64][64], vs[64][64], os[64][65], is_[64], lfs[64];
    const int b = blockIdx.x / 4, h = blockIdx.x % 4, lane = threadIdx.x;
    float C[64], n[64];
#pragma unroll
    for (int d = 0; d < 64; ++d) { C[d] = 0.f; n[d] = 0.f; }
    float mst = 0.f;
    for (int ch = 0; ch < SEQ / 64; ++ch) {
        const int t = ch * 64 + lane; const size_t row = (size_t)b * SEQ + t; const bf16* p = P + row * DINP;
        for (int c = 0; c < 64; ++c) { float yq = 0.f, yk = 0.f;
#pragma unroll
            for (int j = 0; j < 4; ++j) { const int tt = t - 3 + j;
                if (tt >= 0) { const bf16* pp = P + ((size_t)b * SEQ + tt) * DINP;
                    yq += conv[j * 512 + h * 64 + c] * bf2f(pp[C_MQ + h * 64 + c]);
                    yk += conv[j * 512 + 256 + h * 64 + c] * bf2f(pp[C_MK + h * 64 + c]); } }
            qs[lane][c] = siluf_(yq); ks[lane][c] = siluf_(yk) * 0.125f; vs[lane][c] = bf2f(p[C_MV + h * 64 + c]); }
        is_[lane] = bf2f(p[C_MI + h]) + b_i[h]; lfs[lane] = logsigf_(bf2f(p[C_MF + h]) + b_f[h]);
        __syncthreads();
        for (int tt = 0; tt < 64; ++tt) {
            const float lf = lfs[tt], ii = is_[tt]; const float mn = fmaxf(lf + mst, ii);
            const float fs = __expf(lf + mst - mn), iw = __expf(ii - mn); mst = mn;
            const float v = vs[tt][lane]; float num = 0.f, den = 0.f;
#pragma unroll
            for (int d = 0; d < 64; ++d) { const float kk = iw * ks[tt][d]; C[d] = fs * C[d] + kk * v; n[d] = fs * n[d] + kk; const float q = qs[tt][d]; num += q * C[d]; den += q * n[d]; }
            os[tt][lane] = num / fmaxf(fabsf(den), __expf(-mn)); }
        __syncthreads();
        for (int c = 0; c < 64; ++c) Y[row * D + 768 + h * 64 + c] = f2bf(sigmoidf_(bf2f(p[C_MO + h * 64 + c])) * os[lane][c]);
        __syncthreads();
    }
}
__global__ __launch_bounds__(256) void v0_attn(const bf16* Q, const bf16* Kb, const bf16* VT, bf16* O) {
    __shared__ float qsh[4][256], ps[4][256];
    const int lane = threadIdx.x & 63, w = threadIdx.x >> 6; const int idx = blockIdx.x * 4 + w, m = idx >> 2, hd = idx & 3, b = m / SEQ;
    for (int j = 0; j < 4; ++j) qsh[w][lane + 64 * j] = bf2f(Q[(size_t)m * D + hd * 256 + lane + 64 * j]);
    __syncthreads();
    float s[4]; float mx = -3.0e38f;
    for (int jj = 0; jj < 4; ++jj) { const int j = lane + 64 * jj; const uint4* kr = (const uint4*)(Kb + ((size_t)(b * 256 + j)) * 1024 + hd * 256); float a = 0.f;
        for (int d8 = 0; d8 < 32; ++d8) { const uint4 kv = kr[d8]; const unsigned u[4] = {kv.x, kv.y, kv.z, kv.w};
#pragma unroll
            for (int e = 0; e < 4; ++e) a += qsh[w][d8 * 8 + 2 * e] * __uint_as_float(u[e] << 16) + qsh[w][d8 * 8 + 2 * e + 1] * __uint_as_float(u[e] & 0xffff0000u); }
        s[jj] = a; mx = fmaxf(mx, a); }
    mx = wave_max(mx); float sum = 0.f;
    for (int jj = 0; jj < 4; ++jj) { s[jj] = __expf(s[jj] - mx); sum += s[jj]; }
    sum = wave_sum(sum); const float inv = 1.f / sum;
    for (int jj = 0; jj < 4; ++jj) ps[w][lane + 64 * jj] = s[jj] * inv;
    __syncthreads();
    for (int dd = 0; dd < 4; ++dd) { const int d = lane + 64 * dd; const uint4* vr = (const uint4*)(VT + ((size_t)b * 1024 + hd * 256 + d) * 256); float o = 0.f;
        for (int j8 = 0; j8 < 32; ++j8) { const uint4 vv = vr[j8]; const unsigned u[4] = {vv.x, vv.y, vv.z, vv.w};
#pragma unroll
            for (int e = 0; e < 4; ++e) o += ps[w][j8 * 8 + 2 * e] * __uint_as_float(u[e] << 16) + ps[w][j8 * 8 + 2 * e + 1] * __uint_as_float(u[e] & 0xffff0000u); }
        O[(size_t)m * D + hd * 256 + d] = f2bf(o); }
}
__global__ __launch_bounds__(256) void v0_final(float* x, const float* part, const float* g) {
    const int lane = threadIdx.x & 63, row = blockIdx.x * 4 + (threadIdx.x >> 6);
    const float r = row_rstd(part, row); f32x4* xr = (f32x4*)(x + (size_t)row * D); const f32x4* gr = (const f32x4*)g;
#pragma unroll
    for (int j = 0; j < 4; ++j) { f32x4 v = xr[lane + 64 * j]; const f32x4 gg = gr[lane + 64 * j]; v = v * r * gg; xr[lane + 64 * j] = v; }
}

extern "C" void kernel_launch(void* const* d_in, const int* in_sizes, int n_in, void* d_out, int out_size, void* d_ws, size_t ws_size, hipStream_t stream) {
    if (n_in != 25 || ws_size < WS_END) { fprintf(stderr, "kernel_launch: unexpected inputs (n_in %d, ws %zu)\n", n_in, ws_size); return; }
    const float* x = (const float*)d_in[0]; const float* mem = (const float*)d_in[1]; const int* pos = (const int*)d_in[2];
    const float* g_ffa = (const float*)d_in[3]; const float* w_ffa_gu = (const float*)d_in[4]; const float* w_ffa_down = (const float*)d_in[5];
    const float* g_mix = (const float*)d_in[6]; const float* w_in = (const float*)d_in[7]; const float* gla_w_a2 = (const float*)d_in[8];
    const float* gla_b_a = (const float*)d_in[9]; const float* gla_g_norm = (const float*)d_in[10]; const float* ret_g_norm = (const float*)d_in[11];
    const float* ml_conv = (const float*)d_in[12]; const float* ml_b_i = (const float*)d_in[13]; const float* ml_b_f = (const float*)d_in[14];
    const float* w_out = (const float*)d_in[15]; const float* g_xa = (const float*)d_in[16]; const float* g_mem = (const float*)d_in[17];
    const float* w_xa_q = (const float*)d_in[18]; const float* w_xa_kv = (const float*)d_in[19]; const float* w_xa_o = (const float*)d_in[20];
    const float* g_ffb = (const float*)d_in[21]; const float* w_ffb_gu = (const float*)d_in[22]; const float* w_ffb_down = (const float*)d_in[23];
    const float* g_final = (const float*)d_in[24];
    unsigned char* ws = (unsigned char*)d_ws; float* out = (float*)d_out;
    float2* rope = (float2*)(ws + WS_ROPE); float* part = (float*)(ws + WS_PART); bf16* memb = (bf16*)(ws + WS_MEMB);
    bf16* KB = (bf16*)(ws + WS_KB); bf16* VT = (bf16*)(ws + WS_VT); bf16* XB = (bf16*)(ws + WS_XB); bf16* P = (bf16*)(ws + WS_P); bf16* Y = (bf16*)(ws + WS_Y);
    bf16* H = (bf16*)(ws + WS_H); bf16* Q = (bf16*)(ws + WS_Q); bf16* O = (bf16*)(ws + WS_O);
    float* mempart = (float*)(ws + WS_ST);

    v0_stats<<<M / 4, 256, 0, stream>>>(x, XB, part, M);
    v0_stats<<<1024 / 4, 256, 0, stream>>>(mem, memb, mempart, 1024);
    v0_rope<<<M * 16 / 256, 256, 0, stream>>>(pos, rope);
    for (int l = 0; l < DEPTH; ++l) {
        EpiKV E{mempart, KB + (size_t)l * 1024 * 1024, VT + (size_t)l * 4 * 1024 * 256};
        v0_gemm<EpiKV, false><<<dim3(2048 / 128, 1024 / 128), 256, 0, stream>>>(memb, D, w_xa_kv + (size_t)l * D * 2048, 2048, 2048, 0, g_mem + l * D, E);
    }
    for (int l = 0; l < DEPTH; ++l) {
        const float* xin = (l == 0) ? x : out;
        { EpiSwiglu E{part, H}; v0_gemm<EpiSwiglu, true><<<dim3(DFF / 128, M / 128), 256, 0, stream>>>(XB, D, w_ffa_gu + (size_t)l * D * 2 * DFF, 2 * DFF, DFF, DFF, g_ffa + l * D, E); }
        { EpiRes E{xin, out, 0.5f}; v0_gemm<EpiRes, false><<<dim3(D / 128, M / 128), 256, 0, stream>>>(H, DFF, w_ffa_down + (size_t)l * DFF * D, D, D, 0, nullptr, E); }
        v0_stats<<<M / 4, 256, 0, stream>>>(out, XB, part, M);
        { EpiScale E{part, P, DINP, 1.f}; v0_gemm<EpiScale, false><<<dim3(27, M / 128), 256, 0, stream>>>(XB, D, w_in + (size_t)l * D * DIN, DIN, DIN, 0, g_mix + l * D, E); }
        v0_gla<<<BATCH * 6, 64, 0, stream>>>(P, gla_w_a2 + (size_t)l * 16 * 192, gla_b_a + l * 192, gla_g_norm + l * 384, Y);
        v0_ret<<<BATCH * 6, 64, 0, stream>>>(P, rope, ret_g_norm + l * 384, Y);
        v0_mlstm<<<BATCH * 4, 64, 0, stream>>>(P, ml_conv + (size_t)l * 4 * 512, ml_b_i + l * 4, ml_b_f + l * 4, Y);
        { EpiRes E{out, out, 1.0f}; v0_gemm<EpiRes, false><<<dim3(D / 128, M / 128), 256, 0, stream>>>(Y, D, w_out + (size_t)l * D * D, D, D, 0, nullptr, E); }
        v0_stats<<<M / 4, 256, 0, stream>>>(out, XB, part, M);
        { EpiScale E{part, Q, D, 0.0625f}; v0_gemm<EpiScale, false><<<dim3(D / 128, M / 128), 256, 0, stream>>>(XB, D, w_xa_q + (size_t)l * D * D, D, D, 0, g_xa + l * D, E); }
        v0_attn<<<M, 256, 0, stream>>>(Q, KB + (size_t)l * 1024 * 1024, VT + (size_t)l * 4 * 1024 * 256, O);
        { EpiRes E{out, out, 1.0f}; v0_gemm<EpiRes, false><<<dim3(D / 128, M / 128), 256, 0, stream>>>(O, D, w_xa_o + (size_t)l * D * D, D, D, 0, nullptr, E); }
        v0_stats<<<M / 4, 256, 0, stream>>>(out, XB, part, M);
        { EpiSwiglu E{part, H}; v0_gemm<EpiSwiglu, true><<<dim3(DFF / 128, M / 128), 256, 0, stream>>>(XB, D, w_ffb_gu + (size_t)l * D * 2 * DFF, 2 * DFF, DFF, DFF, g_ffb + l * D, E); }
        { EpiRes E{out, out, 0.5f}; v0_gemm<EpiRes, false><<<dim3(D / 128, M / 128), 256, 0, stream>>>(H, DFF, w_ffb_down + (size_t)l * DFF * D, D, D, 0, nullptr, E); }
        v0_stats<<<M / 4, 256, 0, stream>>>(out, XB, part, M);
    }
    v0_final<<<M / 4, 256, 0, stream>>>(out, part, g_final);
}
```

```cpp
#include <hip/hip_runtime.h>
#include <cstdio>
#include <cstdint>

typedef unsigned short bf16;
typedef short bf16x8 __attribute__((ext_vector_type(8)));
typedef float f32x4 __attribute__((ext_vector_type(4)));
typedef float f32x16 __attribute__((ext_vector_type(16)));
typedef unsigned u32x4 __attribute__((ext_vector_type(4)));
#define DI __device__ __forceinline__
#define LAS __attribute__((address_space(3)))

constexpr int BATCH = 4, SEQ = 8192, D = 1024, DEPTH = 4, MEMLEN = 256;
constexpr int M = BATCH * SEQ;
constexpr int DFF = 2816, DIN = 3352, DINP = 3584;
constexpr float EPS = 1e-6f;
constexpr int C_GQ = 0, C_GK = 192, C_GV = 384, C_GA = 768, C_GR = 784, C_RQ = 1168, C_RK = 1360, C_RV = 1552, C_RG = 1936,
              C_MQ = 2320, C_MK = 2576, C_MV = 2832, C_MO = 3088, C_MI = 3344, C_MF = 3348;

constexpr size_t MiB = 1u << 20;
constexpr size_t WS_CTL = 0, WS_ROPE = 1 * MiB, WS_PART = 5 * MiB, WS_MEMB = 7 * MiB, WS_MEMP = 9 * MiB, WS_KB = 10 * MiB, WS_VT = 18 * MiB,
                 WS_WKV = 26 * MiB, WS_WL = 42 * MiB, WS_XB = 88 * MiB, WS_R = 152 * MiB,
                 WS_P = WS_R, WS_ST = 376 * MiB, WS_Y = 420 * MiB, WS_H = WS_R, WS_Q = WS_R, WS_O = 216 * MiB, WS_END = 484 * MiB;
constexpr size_t WL_GUA = 0, WL_DNA = WL_GUA + (size_t)2 * DFF * D * 2, WL_IN = WL_DNA + (size_t)D * DFF * 2, WL_OUT = WL_IN + (size_t)DINP * D * 2,
                 WL_XQ = WL_OUT + (size_t)D * D * 2, WL_XO = WL_XQ + (size_t)D * D * 2, WL_GUB = WL_XO + (size_t)D * D * 2, WL_DNB = WL_GUB + (size_t)2 * DFF * D * 2,
                 WL_END = WL_DNB + (size_t)D * DFF * 2;
static_assert(WS_WL + WL_END <= WS_XB, "per-layer weights fit");
static_assert(WS_P + (size_t)M * DINP * 2 <= WS_ST && WS_H + (size_t)M * DFF * 2 <= WS_ST && WS_Y + (size_t)M * D * 2 <= WS_END, "ws map");
constexpr int CW_BAR = 4096;

DI float bf2f(bf16 b) { return __uint_as_float(((unsigned)b) << 16); }
DI bf16 f2bf(float f) { unsigned u = __float_as_uint(f); return (bf16)((u + 0x7fffu + ((u >> 16) & 1u)) >> 16); }
typedef float f32x2_t_ __attribute__((ext_vector_type(2)));
typedef __bf16 bf16x2_t_ __attribute__((ext_vector_type(2)));
DI unsigned pk2(float lo, float hi) { const f32x2_t_ v = {lo, hi}; const bf16x2_t_ b = __builtin_convertvector(v, bf16x2_t_); return __builtin_bit_cast(unsigned, b); }
DI float sigmoidf_(float x) { return __builtin_amdgcn_rcpf(1.f + __expf(-x)); }
DI float siluf_(float x) { return x * __builtin_amdgcn_rcpf(1.f + __expf(-x)); }
DI float logsigf_(float x) { return fminf(x, 0.f) - __logf(1.f + __expf(-fabsf(x))); }
DI float wave_sum(float v) {
#pragma unroll
    for (int o = 1; o < 64; o <<= 1) v += __shfl_xor(v, o);
    return v;
}
DI float wave_max(float v) {
#pragma unroll
    for (int o = 1; o < 64; o <<= 1) v = fmaxf(v, __shfl_xor(v, o));
    return v;
}
DI float row_rstd(const float* part, int row) {
    const f32x4* p = (const f32x4*)(part + (size_t)row * 16);
    const f32x4 a = p[0], b = p[1], c = p[2], d = p[3];
    const float s = ((a.x + a.y) + (a.z + a.w)) + ((b.x + b.y) + (b.z + b.w)) + ((c.x + c.y) + (c.z + c.w)) + ((d.x + d.y) + (d.z + d.w));
    return rsqrtf(s * (1.f / D) + EPS);
}
DI int lane_id() { return (int)__builtin_amdgcn_mbcnt_hi(~0u, __builtin_amdgcn_mbcnt_lo(~0u, 0u)); }
namespace pg8 {
#define PG8_LAS __attribute__((address_space(3)))
typedef unsigned short bf16_t;
typedef short bf16x8 __attribute__((ext_vector_type(8)));
typedef float f32x4 __attribute__((ext_vector_type(4)));
typedef unsigned u32x4 __attribute__((ext_vector_type(4)));
constexpr int BM = 256, BK = 64, HALF = 128, HTB = HALF * BK * 2  , STAGE_BYTES = 8 * HTB, NXCD = 8, WGM = 8;

__host__ __device__ __forceinline__ int lds_byte(int r, int c) { const int st = (r >> 4) * 2 + (c >> 5), rr = r & 15, cc = c & 31, ob = rr * 64 + cc * 2; return st * 1024 + (ob ^ (((ob >> 9) & 1) << 5)); }
__host__ __device__ __forceinline__ void stage_rc(int b, int& R, int& C) { const int st = b / 1024, sb = b % 1024, swz = sb ^ (((sb >> 9) & 1) << 5); R = (st >> 1) * 16 + swz / 64; C = (st & 1) * 32 + (swz % 64) / 2; }
__host__ __device__ __forceinline__ int perm32(int rho) { const int n = rho >> 4, i = rho & 15; return 8 * (i >> 2) + 4 * n + (i & 3); }

struct Unit { int pm, pn; };
struct Gemm { const bf16_t* A; const bf16_t* Bt; int M, N, K; };

struct StaticOrder {
    int nM, nN, nwg, G, c;
    __host__ __device__ void init(int M, int N, int G_, int c_) { nM = M / BM; nN = N / BM; nwg = nM * nN; G = G_; c = c_; }
    __host__ __device__ bool next(int i, Unit& u) const {
        const long L = (long)i * G + c; if (L >= nwg) return false;
        int wgid = (int)L; { const int q = nwg / NXCD, r = nwg % NXCD, xcd = wgid % NXCD, off = wgid / NXCD; wgid = (xcd < r ? xcd * (q + 1) : r * (q + 1) + (xcd - r) * q) + off; }
        const int nig = WGM * nN, gid = wgid / nig, fm = gid * WGM, gsz = (nM - fm) < WGM ? (nM - fm) : WGM;
        u.pm = fm + ((wgid % nig) % gsz); u.pn = (wgid % nig) / gsz; return true;
    }
    __device__ __forceinline__ void a_ready(const Unit&) const {}
    __device__ __forceinline__ void done(const Unit&) const {}
};

__device__ __forceinline__ unsigned cvt_pk_bf16(float lo, float hi) { unsigned r; asm volatile("v_cvt_pk_bf16_f32 %0, %1, %2" : "=v"(r) : "v"(lo), "v"(hi)); return r; }
__device__ __forceinline__ u32x4 pack8(const f32x4 v0, const f32x4 v1) { u32x4 w; w.x = cvt_pk_bf16(v0[0], v0[1]); w.y = cvt_pk_bf16(v0[2], v0[3]); w.z = cvt_pk_bf16(v1[0], v1[1]); w.w = cvt_pk_bf16(v1[2], v1[3]); return w; }
__device__ __forceinline__ f32x4 silu4(const f32x4 a) { f32x4 r; r[0] = siluf_(a[0]); r[1] = siluf_(a[1]); r[2] = siluf_(a[2]); r[3] = siluf_(a[3]); return r; }

struct EpiSwiglu {
    static constexpr bool PERM = true, AFTER_DRAIN = false;
    const float* part; bf16_t* H;
    __device__ __forceinline__ void operator()(const f32x4 (&acc)[2][2][4][2], const Unit& u, int wr, int wc, int fr, int fq) const {
        const int row0 = u.pm * BM + wr * 64 + fr, col0 = u.pn * 128 + wc * 32 + 8 * fq;
#pragma unroll
        for (int ai = 0; ai < 2; ++ai)
#pragma unroll
            for (int m = 0; m < 4; ++m) { const int row = row0 + ai * HALF + m * 16; const float rs = row_rstd(part, row);
                const f32x4 a0 = acc[ai][0][m][0] * rs, a1 = acc[ai][0][m][1] * rs, g0 = acc[ai][1][m][0] * rs, g1 = acc[ai][1][m][1] * rs;
                *(u32x4*)(H + (size_t)row * DFF + col0) = pack8(silu4(a0) * g0, silu4(a1) * g1); }
    }
};
struct EpiRes {
    static constexpr bool PERM = true, AFTER_DRAIN = false;
    const float* xin; float* xout; bf16_t* xb; float* part; float alpha;
    __device__ __forceinline__ void operator()(const f32x4 (&acc)[2][2][4][2], const Unit& u, int wr, int wc, int fr, int fq) const {
        const int row0 = u.pm * BM + wr * 64 + fr, col0 = u.pn * BM + wc * 32 + 8 * fq;
#pragma unroll
        for (int ai = 0; ai < 2; ++ai)
#pragma unroll
            for (int m = 0; m < 4; ++m) { const int row = row0 + ai * HALF + m * 16; const size_t off = (size_t)row * D + col0; float ss = 0.f;
#pragma unroll
                for (int bj = 0; bj < 2; ++bj) { const f32x4 x0 = *(const f32x4*)(xin + off + bj * HALF), x1 = *(const f32x4*)(xin + off + bj * HALF + 4);
                    const f32x4 y0 = x0 + acc[ai][bj][m][0] * alpha, y1 = x1 + acc[ai][bj][m][1] * alpha;
                    *(f32x4*)(xout + off + bj * HALF) = y0; *(f32x4*)(xout + off + bj * HALF + 4) = y1;
                    *(u32x4*)(xb + off + bj * HALF) = pack8(y0, y1);
                    ss += ((y0[0] * y0[0] + y0[1] * y0[1]) + (y0[2] * y0[2] + y0[3] * y0[3])) + ((y1[0] * y1[0] + y1[1] * y1[1]) + (y1[2] * y1[2] + y1[3] * y1[3])); }
                ss += __shfl_xor(ss, 16); ss += __shfl_xor(ss, 32);
                if (fq == 0) part[(size_t)row * 16 + u.pn * 4 + wc] = ss; }
    }
};
struct EpiScale {
    static constexpr bool PERM = true, AFTER_DRAIN = false;
    const float* part; bf16_t* O; int ldc; float scale;
    __device__ __forceinline__ void operator()(const f32x4 (&acc)[2][2][4][2], const Unit& u, int wr, int wc, int fr, int fq) const {
        const int row0 = u.pm * BM + wr * 64 + fr, col0 = u.pn * BM + wc * 32 + 8 * fq;
#pragma unroll
        for (int ai = 0; ai < 2; ++ai)
#pragma unroll
            for (int m = 0; m < 4; ++m) { const int row = row0 + ai * HALF + m * 16; const float rs = row_rstd(part, row) * scale; bf16_t* rowp = O + (size_t)row * ldc + col0;
#pragma unroll
                for (int bj = 0; bj < 2; ++bj) *(u32x4*)(rowp + bj * HALF) = pack8(acc[ai][bj][m][0] * rs, acc[ai][bj][m][1] * rs); }
    }
};
struct EpiKV {
    static constexpr bool PERM = true, AFTER_DRAIN = false;
    const float* mp; bf16_t* KB; bf16_t* VT;
    __device__ __forceinline__ void operator()(const f32x4 (&acc)[2][2][4][2], const Unit& u, int wr, int wc, int fr, int fq) const {
        const int l = u.pn >> 3, pc = u.pn & 7; const int row0 = u.pm * BM + wr * 64 + fr;
#pragma unroll
        for (int ai = 0; ai < 2; ++ai)
#pragma unroll
            for (int m = 0; m < 4; ++m) { const int row = row0 + ai * HALF + m * 16; const float rs = rsqrtf(mp[(size_t)row * 16] * (1.f / D) + EPS);
#pragma unroll
                for (int bj = 0; bj < 2; ++bj) { const f32x4 v0 = acc[ai][bj][m][0] * rs, v1 = acc[ai][bj][m][1] * rs;
                    if (pc < 4) { *(u32x4*)(KB + ((size_t)l * 1024 + row) * 1024 + pc * 256 + bj * HALF + wc * 32 + 8 * fq) = pack8(v0, v1); }
                    else { const int vc = (pc - 4) * 256 + bj * HALF + wc * 32 + 8 * fq; bf16_t* vp = VT + (((size_t)l * 4 + u.pm) * 1024 + vc) * 256 + (row & 255);
#pragma unroll
                        for (int e = 0; e < 4; ++e) { vp[(size_t)e * 256] = f2bf(v0[e]); vp[(size_t)(e + 4) * 256] = f2bf(v1[e]); } } } }
    }
};
template <class Epi, class Sched, bool ALIGN_EPI = false, bool SP2 = false>
__device__ __forceinline__ void gemm_phase(PG8_LAS unsigned char* lds, const Gemm g, const Sched& S, const Epi& E, const int wave_) {
    int tid_ = wave_ * 64 + lane_id(); asm volatile("" : "+v"(tid_));
    const int tid = tid_, wid = wave_, lane = tid & 63, wr = wid >> 2, wc = wid & 3, fr = lane & 15, fq = lane >> 4;
    const int K = g.K, nt = K / BK;
    unsigned voffA[2], voffB[2];
#pragma unroll
    for (int i = 0; i < 2; ++i) { int R, C; stage_rc(tid * 16 + i * 8192, R, C); const int Rb = Epi::PERM ? ((R & ~31) + perm32(R & 31)) : R;
        voffA[i] = (unsigned)(R * K + C) * 2u; voffB[i] = (unsigned)(Rb * K + C) * 2u; }
    const size_t kstep = (size_t)(BK * 2);
    const size_t hstep = (size_t)HALF * K * 2;
    const size_t tstep = 2 * hstep;
    const unsigned ldsw = (unsigned)wid * 1024u;
    const int aoff = lds_byte(wr * 64 + fr, fq * 8), boff = lds_byte(wc * 32 + fr, fq * 8);
#define PG8_SA(b, h) (((b) * 2 + (h)) * HTB)
#define PG8_SB(b, h) ((4 + (b) * 2 + (h)) * HTB)
#define PG8_STAGE(bufoff, gbase, voff) do { _Pragma("unroll") for (int _i = 0; _i < 2; ++_i) \
        __builtin_amdgcn_global_load_lds((const unsigned*)((const char*)(gbase) + (voff)[_i]), (PG8_LAS unsigned*)(lds + (bufoff) + ldsw + _i * 8192), 16, 0, 0); } while (0)
#define PG8_LDA(dst, b, h) do { _Pragma("unroll") for (int m = 0; m < 4; ++m) _Pragma("unroll") for (int k = 0; k < 2; ++k) dst[m][k] = *(const PG8_LAS bf16x8*)(lds + PG8_SA(b, h) + aoff + m * 2048 + k * 1024); } while (0)
#define PG8_LDB(dst, b, h) do { _Pragma("unroll") for (int n = 0; n < 2; ++n) _Pragma("unroll") for (int k = 0; k < 2; ++k) dst[n][k] = *(const PG8_LAS bf16x8*)(lds + PG8_SB(b, h) + boff + n * 2048 + k * 1024); } while (0)
#define PG8_MMA(ai, bj, At, Bt) do { __builtin_amdgcn_s_setprio(1); _Pragma("unroll") for (int m = 0; m < 4; ++m) _Pragma("unroll") for (int n = 0; n < 2; ++n) _Pragma("unroll") for (int k = 0; k < 2; ++k) \
        acc[ai][bj][m][n] = __builtin_amdgcn_mfma_f32_16x16x32_bf16(Bt[n][k], At[m][k], acc[ai][bj][m][n], 0, 0, 0); __builtin_amdgcn_s_setprio(0); } while (0)
#define PG8_WAIT_V(n) asm volatile("s_waitcnt vmcnt(" #n ")" ::: "memory")
#define PG8_WAIT_L(n) asm volatile("s_waitcnt lgkmcnt(" #n ")" ::: "memory")
#define PG8_BAR __builtin_amdgcn_s_barrier()
#define PG8_SCHED __builtin_amdgcn_sched_barrier(0)
    Unit cur, nxt; int ui = 0;
    if (!S.next(0, cur)) return;
    f32x4 acc[2][2][4][2];
#pragma unroll
    for (int a = 0; a < 2; ++a)
#pragma unroll
        for (int b = 0; b < 2; ++b)
#pragma unroll
            for (int m = 0; m < 4; ++m)
#pragma unroll
                for (int n = 0; n < 2; ++n) acc[a][b][m][n] = (f32x4){0.f, 0.f, 0.f, 0.f};
    bf16x8 At[4][2], B0[2][2], B1[2][2];
    const char* cA = (const char*)g.A + (size_t)cur.pm * tstep; const char* cB = (const char*)g.Bt + (size_t)cur.pn * tstep;
    S.a_ready(cur);
    if constexpr (SP2) {
        PG8_STAGE(PG8_SB(0, 0), cB, voffB); PG8_STAGE(PG8_SB(0, 1), cB + hstep, voffB); PG8_STAGE(PG8_SA(0, 0), cA, voffA); PG8_STAGE(PG8_SA(0, 1), cA + hstep, voffA);
        if (wr == 1) PG8_BAR;
        PG8_WAIT_V(2); PG8_BAR;
        PG8_STAGE(PG8_SB(1, 0), cB + kstep, voffB); PG8_STAGE(PG8_SA(1, 0), cA + kstep, voffA); PG8_STAGE(PG8_SB(1, 1), cB + hstep + kstep, voffB);
        PG8_WAIT_V(6); PG8_BAR;
    } else {
        PG8_STAGE(PG8_SB(0, 0), cB, voffB); PG8_STAGE(PG8_SA(0, 0), cA, voffA); PG8_STAGE(PG8_SB(0, 1), cB + hstep, voffB); PG8_STAGE(PG8_SA(0, 1), cA + hstep, voffA);
        if (wr == 1) PG8_BAR;
        PG8_WAIT_V(4); PG8_BAR;
        PG8_STAGE(PG8_SB(1, 0), cB + kstep, voffB); PG8_STAGE(PG8_SA(1, 0), cA + kstep, voffA); PG8_STAGE(PG8_SB(1, 1), cB + hstep + kstep, voffB);
        PG8_WAIT_V(6); PG8_BAR;
    }
    for (;;) {
        const bool has_next = S.next(ui + 1, nxt);
        const char* nA = has_next ? (const char*)g.A + (size_t)nxt.pm * tstep : cA; const char* nB = has_next ? (const char*)g.Bt + (size_t)nxt.pn * tstep : cB;
        for (int t = 0; t < nt; t += 2) {
            const bool last = (t == nt - 2);
            const char* a1 = cA + (size_t)(t + 1) * kstep;
            const char* a2 = last ? nA : cA + (size_t)(t + 2) * kstep; const char* b2 = last ? nB : cB + (size_t)(t + 2) * kstep;
            const char* a3 = a2 + kstep; const char* b3 = b2 + kstep;
            if (last && has_next) S.a_ready(nxt);
            if constexpr (SP2) {
            PG8_LDB(B0, 0, 0); PG8_LDB(B1, 0, 1); PG8_SCHED; PG8_LDA(At, 0, 0); PG8_STAGE(PG8_SA(1, 1), a1 + hstep, voffA);
            PG8_WAIT_V(8); PG8_WAIT_L(0); PG8_BAR; PG8_MMA(0, 0, At, B0); PG8_MMA(0, 1, At, B1); PG8_BAR; PG8_SCHED;
            PG8_LDA(At, 0, 1); PG8_STAGE(PG8_SB(0, 0), b2, voffB); PG8_STAGE(PG8_SB(0, 1), b2 + hstep, voffB); PG8_STAGE(PG8_SA(0, 0), a2, voffA);
            PG8_WAIT_V(8); PG8_WAIT_L(0); PG8_BAR; PG8_MMA(1, 0, At, B0); PG8_MMA(1, 1, At, B1); PG8_BAR; PG8_SCHED;
            PG8_LDB(B0, 1, 0); PG8_LDB(B1, 1, 1); PG8_SCHED; PG8_LDA(At, 1, 0); PG8_STAGE(PG8_SA(0, 1), a2 + hstep, voffA);
            PG8_WAIT_V(8); PG8_WAIT_L(0); PG8_BAR; PG8_MMA(0, 0, At, B0); PG8_MMA(0, 1, At, B1); PG8_BAR; PG8_SCHED;
            PG8_LDA(At, 1, 1); PG8_STAGE(PG8_SB(1, 0), b3, voffB); PG8_STAGE(PG8_SB(1, 1), b3 + hstep, voffB); PG8_STAGE(PG8_SA(1, 0), a3, voffA);
            PG8_WAIT_V(8); PG8_WAIT_L(0); PG8_BAR; PG8_MMA(1, 0, At, B0); PG8_MMA(1, 1, At, B1); PG8_BAR; PG8_SCHED;
            } else {
            PG8_LDB(B0, 0, 0); PG8_SCHED; PG8_LDA(At, 0, 0); PG8_STAGE(PG8_SA(1, 1), a1 + hstep, voffA);
            PG8_WAIT_L(8); PG8_BAR; PG8_WAIT_L(0); PG8_MMA(0, 0, At, B0); PG8_BAR; PG8_SCHED;
            PG8_LDB(B1, 0, 1); PG8_STAGE(PG8_SB(0, 0), b2, voffB);
            PG8_BAR; PG8_WAIT_L(0); PG8_MMA(0, 1, At, B1); PG8_BAR;
            PG8_LDA(At, 0, 1); PG8_STAGE(PG8_SA(0, 0), a2, voffA);
            PG8_BAR; PG8_WAIT_L(0); PG8_MMA(1, 0, At, B0); PG8_BAR; PG8_SCHED;
            PG8_STAGE(PG8_SB(0, 1), b2 + hstep, voffB);
            PG8_WAIT_V(6); PG8_BAR; PG8_MMA(1, 1, At, B1); PG8_BAR;
            PG8_LDB(B0, 1, 0); PG8_SCHED; PG8_LDA(At, 1, 0); PG8_STAGE(PG8_SA(0, 1), a2 + hstep, voffA);
            PG8_WAIT_L(8); PG8_BAR; PG8_WAIT_L(0); PG8_MMA(0, 0, At, B0); PG8_BAR; PG8_SCHED;
            PG8_LDB(B1, 1, 1); PG8_STAGE(PG8_SB(1, 0), b3, voffB);
            PG8_BAR; PG8_WAIT_L(0); PG8_MMA(0, 1, At, B1); PG8_BAR;
            PG8_LDA(At, 1, 1); PG8_STAGE(PG8_SA(1, 0), a3, voffA);
            PG8_BAR; PG8_WAIT_L(0); PG8_MMA(1, 0, At, B0); PG8_BAR; PG8_SCHED;
            PG8_STAGE(PG8_SB(1, 1), b3 + hstep, voffB);
            PG8_WAIT_V(6); PG8_BAR; PG8_MMA(1, 1, At, B1); PG8_BAR;
            }
        }
        if constexpr (ALIGN_EPI) { if (wr == 0) PG8_BAR; }
        if constexpr (!Epi::AFTER_DRAIN) { E(acc, cur, wr, wc, fr, fq); S.done(cur); }
        if (!has_next) break;
#pragma unroll
        for (int a = 0; a < 2; ++a)
#pragma unroll
            for (int b = 0; b < 2; ++b)
#pragma unroll
                for (int m = 0; m < 4; ++m)
#pragma unroll
                    for (int n = 0; n < 2; ++n) acc[a][b][m][n] = (f32x4){0.f, 0.f, 0.f, 0.f};
        cur = nxt; cA = nA; cB = nB; ++ui;
        if constexpr (ALIGN_EPI) { if (wr == 1) PG8_BAR; }
    }
    PG8_WAIT_V(0);
    if constexpr (!ALIGN_EPI) { if (wr == 0) PG8_BAR; }
    PG8_BAR;
    if constexpr (Epi::AFTER_DRAIN) { E.fused(acc, cur, wr, wc, fr, fq, lds, wid, lane); S.done(cur); }
#undef PG8_SA
#undef PG8_SB
#undef PG8_STAGE
#undef PG8_LDA
#undef PG8_LDB
#undef PG8_MMA
#undef PG8_WAIT_V
#undef PG8_WAIT_L
#undef PG8_BAR
#undef PG8_SCHED
}
}
#define XB_TMO      128
#define XB_XCNT(j)  (256  + 64 * (j))
#define XB_XSUB(j)  (1280 + 64 * (j))
#define XB_XGEN(j)  (2304 + 64 * (j))
#define XB_TOP      3328
#define XB_TOPGEN   3392
#define XCD_BAR_WORDS 3456
#define XB_SPIN_CAP (1u << 18)

__device__ __forceinline__ unsigned xb_ld(unsigned* p)              { return __hip_atomic_load(p, __ATOMIC_RELAXED, __HIP_MEMORY_SCOPE_AGENT); }
__device__ __forceinline__ unsigned xb_add(unsigned* p, unsigned v) { return __hip_atomic_fetch_add(p, v, __ATOMIC_RELAXED, __HIP_MEMORY_SCOPE_AGENT); }
__device__ __forceinline__ unsigned xb_xcc_id() { return (unsigned)__builtin_amdgcn_s_getreg((3 << 11) | 20) & 0xFu; }
#define XB_SPIN(cond, bar) do { unsigned _sp = 0; while (cond) { __builtin_amdgcn_s_sleep(1); \
    if ((++_sp & 255u) == 0u) { if (xb_ld(&(bar)[XB_TMO])) break; if (_sp > XB_SPIN_CAP) { atomicAdd(&(bar)[XB_TMO], 1u); break; } } } } while (0)

struct XcdBarrier {
    int wave;
    unsigned* bar; unsigned x;
    volatile LAS unsigned* st;
};

__device__ __forceinline__ XcdBarrier xcd_barrier_post(unsigned* bar, volatile LAS unsigned* st, int wave) {
    XcdBarrier b; b.wave = wave; b.bar = bar; b.x = xb_xcc_id(); b.st = st;
    if (wave == 0 && lane_id() == 0) (void)xb_add(&bar[XB_XCNT(b.x)], 1u);
    return b;
}
__device__ __forceinline__ void xcd_barrier_complete(unsigned* bar, unsigned x, unsigned& nloc, unsigned& nx) {
    const unsigned G = gridDim.x * gridDim.y * gridDim.z;
    unsigned sum, cnt, mine, sp = 0u;
    for (;;) {
        sum = 0u; cnt = 0u; mine = 0u;
#pragma unroll
        for (unsigned j = 0; j < 16; ++j) { const unsigned c = xb_ld(&bar[XB_XCNT(j)]); sum += c; cnt += (c > 0u) ? 1u : 0u; mine = (j == x) ? c : mine; }
        if (sum == G) break;
        __builtin_amdgcn_s_sleep(1);
        if ((++sp & 255u) == 0u) { if (xb_ld(&bar[XB_TMO])) break; if (sp > XB_SPIN_CAP) { atomicAdd(&bar[XB_TMO], 1u); break; } }
    }
    nloc = mine > 0u ? mine : 1u; nx = cnt > 0u ? cnt : 1u;
}

__device__ __forceinline__ void xcd_barrier(const XcdBarrier& b) {
    asm volatile("s_waitcnt vmcnt(0)" ::: "memory");
    __syncthreads();
    if (b.wave == 0 && lane_id() == 0) {
        unsigned* bar = b.bar;
        __builtin_amdgcn_s_waitcnt(0);
        unsigned nloc = b.st[0], nx = b.st[1];
        if (nloc == 0u) { xcd_barrier_complete(bar, b.x, nloc, nx); b.st[0] = nloc; b.st[1] = nx; }
        const unsigned old = xb_add(&bar[XB_XSUB(b.x)], 1u);
        const unsigned gen = old / nloc;
        if (old + 1u == (gen + 1u) * nloc) {
            __builtin_amdgcn_fence(__ATOMIC_RELEASE, "agent");
            asm volatile("s_waitcnt vmcnt(0)" ::: "memory");
            const unsigned og = xb_add(&bar[XB_TOP], 1u);
            const unsigned tg = og / nx;
            if (og + 1u == (tg + 1u) * nx) xb_add(&bar[XB_TOPGEN], 1u);
            else XB_SPIN(xb_ld(&bar[XB_TOPGEN]) == tg, bar);
            __builtin_amdgcn_fence(__ATOMIC_ACQUIRE, "agent");
            xb_add(&bar[XB_XGEN(b.x)], 1u);
            asm volatile("s_waitcnt vmcnt(0)" ::: "memory");
        } else {
            XB_SPIN(xb_ld(&bar[XB_XGEN(b.x)]) == gen, bar);
            __builtin_amdgcn_fence(__ATOMIC_ACQUIRE, "agent");
            asm volatile("s_waitcnt vmcnt(0)" ::: "memory");
        }
    }
    __syncthreads();
}
constexpr int NWAVES = 8, NTHR = 512;
constexpr int RING_BYTES = 131072;
constexpr int WSLICE = 19456;
constexpr int MISC_OFF = NWAVES * WSLICE;
constexpr int LDS_BYTES = MISC_OFF + 512;
static_assert(MISC_OFF >= RING_BYTES && LDS_BYTES <= 163840, "LDS map");
#define LDS_WAIT() asm volatile("s_waitcnt lgkmcnt(0)" ::: "memory")
#define VM_WAIT() asm volatile("s_waitcnt vmcnt(0)" ::: "memory")

struct Args { const void* in[25]; float* out; unsigned char* ws; int ph_lo, ph_hi, li, pad; };

constexpr int PH_PRO = 0, PH_KV = 1, PH_L0 = 2, PH_PER_LAYER = 13, PH_FINAL = PH_L0 + DEPTH * PH_PER_LAYER, PH_END = PH_FINAL + 1;
enum { LP_CONV = 0, LP_GUA, LP_DNA, LP_WIN, LP_MIXA, LP_SCAN, LP_MIXB, LP_WOUT, LP_XQ, LP_ATT, LP_XO, LP_GUB, LP_DNB };

DI void conv_item(const float* W, int ldw, int K, int NP, int nvalid, int mapk, const float* gk, bf16* WT, LAS float* scr, int item, int lane) {
    const int nblk = NP / 32, kb = item / nblk, nb = item % nblk, k0 = 64 * kb, n0 = 32 * nb;
    const int np = n0 + (lane & 31);
    int src = np; bool ok = np < nvalid;
    if (mapk == 1) { const int tile = np >> 8, t = np & 255; src = (t < 128) ? (128 * tile + t) : (DFF + 128 * tile + (t - 128)); ok = true; }
#pragma unroll 8
    for (int i = 0; i < 32; ++i) { const int kk = 2 * i + (lane >> 5); float w = ok ? W[(size_t)(k0 + kk) * ldw + src] : 0.f; if (gk) w *= gk[k0 + kk]; scr[kk * 33 + (lane & 31)] = w; }
    LDS_WAIT();
    const int c = lane & 7;
#pragma unroll
    for (int j = 0; j < 4; ++j) { const int n = (lane >> 3) + 8 * j; const LAS float* s = scr + (8 * c) * 33 + n;
        u32x4 o; o.x = pk2(s[0 * 33], s[1 * 33]); o.y = pk2(s[2 * 33], s[3 * 33]); o.z = pk2(s[4 * 33], s[5 * 33]); o.w = pk2(s[6 * 33], s[7 * 33]);
        *(u32x4*)(WT + (size_t)(n0 + n) * K + k0 + 8 * c) = o; }
    LDS_WAIT();
}
DI int sel8(int j, int a0, int a1, int a2, int a3, int a4, int a5, int a6, int a7) { return j == 0 ? a0 : j == 1 ? a1 : j == 2 ? a2 : j == 3 ? a3 : j == 4 ? a4 : j == 5 ? a5 : j == 6 ? a6 : a7; }
DI const void* argp(const Args& a, int i) { asm volatile("" : "+s"(i)); return a.in[i]; }
enum { I_X = 0, I_MEM, I_POS, I_GFFA, I_WFFAGU, I_WFFADN, I_GMIX, I_WIN, I_GLAWA2, I_GLABA, I_GLAGN, I_RETGN, I_MLCONV, I_MLBI, I_MLBF, I_WOUT, I_GXA, I_GMEM, I_WXQ, I_WXKV, I_WXO, I_GFFB, I_WFFBGU, I_WFFBDN, I_GFINAL };
DI void convert_layer(const Args& args, int l, LAS float* scr, int gw, int ngw, int lane) {
    constexpr int C_GU = (D / 64) * (2 * DFF / 32), C_DN = (DFF / 64) * (D / 32), C_IN = (D / 64) * (DINP / 32), C_SQ = (D / 64) * (D / 32);
    constexpr int NITEMS = 2 * C_GU + 2 * C_DN + C_IN + 3 * C_SQ;
    constexpr int cnt[8] = {C_GU, C_GU, C_DN, C_DN, C_IN, C_SQ, C_SQ, C_SQ};
    for (int it = gw; it < NITEMS; it += ngw) {
        int r = it, j = 0;
#pragma unroll
        for (int q = 0; q < 7; ++q) { if (j == q && r >= cnt[q]) { r -= cnt[q]; j = q + 1; } }
        const int in_idx = sel8(j, I_WFFAGU, I_WFFBGU, I_WFFADN, I_WFFBDN, I_WIN, I_WOUT, I_WXQ, I_WXO);
        const int g_idx = sel8(j, I_GFFA, I_GFFB, -1, -1, I_GMIX, -1, I_GXA, -1);
        const int ldw = sel8(j, 2 * DFF, 2 * DFF, D, D, DIN, D, D, D), K = sel8(j, D, D, DFF, DFF, D, D, D, D), NP = sel8(j, 2 * DFF, 2 * DFF, D, D, DINP, D, D, D);
        const int mapk = j < 2 ? 1 : 0;
        const size_t dst = j == 0 ? WL_GUA : j == 1 ? WL_GUB : j == 2 ? WL_DNA : j == 3 ? WL_DNB : j == 4 ? WL_IN : j == 5 ? WL_OUT : j == 6 ? WL_XQ : WL_XO;
        const float* W = (const float*)args.in[in_idx] + (size_t)l * K * ldw;
        const float* gk = g_idx >= 0 ? (const float*)args.in[g_idx >= 0 ? g_idx : 0] + l * D : nullptr;
        conv_item(W, ldw, K, NP, ldw, mapk, gk, (bf16*)(args.ws + WS_WL + dst), scr, r, lane);
    }
}
DI void convert_kv(const Args& args, LAS float* scr, int gw, int ngw, int lane) {
    constexpr int C_KV = (D / 64) * (2048 / 32);
    const float* wkv = (const float*)argp(args, I_WXKV); const float* gm = (const float*)argp(args, I_GMEM);
    for (int it = gw; it < DEPTH * C_KV; it += ngw) { const int l = it / C_KV, r = it % C_KV;
        conv_item(wkv + (size_t)l * D * 2048, 2048, D, 2048, 2048, 0, gm + l * D, (bf16*)(args.ws + WS_WKV) + (size_t)l * 2048 * D, scr, r, lane); }
}
DI void stats_row(const float* xrow, bf16* xbrow, float* prow, int lane) {
    const f32x4* xr = (const f32x4*)xrow; float s = 0.f;
#pragma unroll
    for (int j = 0; j < 4; ++j) { const f32x4 v = xr[lane + 64 * j]; s += (v.x * v.x + v.y * v.y) + (v.z * v.z + v.w * v.w);
        uint2 o; o.x = pk2(v.x, v.y); o.y = pk2(v.z, v.w); *(uint2*)(xbrow + (lane + 64 * j) * 4) = o; }
    s = wave_sum(s);
    if (lane < 16) prow[lane] = (lane == 0) ? s : 0.f;
}
struct MixCtx { unsigned char* ws; const float *w_a2, *b_a, *gla_gn, *ret_gn, *conv, *b_i, *b_f; };
constexpr int NCH = SEQ / 64;
constexpr size_t ST_G = WS_ST, ST_R = WS_ST + 12 * MiB, ST_M = WS_ST + 24 * MiB, ST_GDEC = WS_ST + 41 * MiB, ST_MLSC = WS_ST + 42 * MiB;
constexpr int ML_BLK = 65 * 64;
static_assert(ST_M + (size_t)16 * NCH * ML_BLK * 2 <= ST_GDEC && ST_MLSC + (size_t)16 * NCH * 16 <= WS_Y, "state map");
constexpr float QK_SCALE32 = 0.17677669529663687f;

DI float blo(unsigned u) { return __uint_as_float(u << 16); }
DI float bhi(unsigned u) { return __uint_as_float(u & 0xffff0000u); }
DI void ld8(const bf16* p, float* o) { const uint4 v = *(const uint4*)p; o[0] = blo(v.x); o[1] = bhi(v.x); o[2] = blo(v.y); o[3] = bhi(v.y); o[4] = blo(v.z); o[5] = bhi(v.z); o[6] = blo(v.w); o[7] = bhi(v.w); }
DI f32x16 mfma32(bf16x8 a, bf16x8 b, f32x16 c) { return __builtin_amdgcn_mfma_f32_32x32x16_bf16(a, b, c, 0, 0, 0); }
DI bf16x8 lfrag(const LAS bf16* base, int ld, int row0, int k0, int lane) { return *(const LAS bf16x8*)(base + (row0 + (lane & 31)) * ld + k0 + 8 * (lane >> 5)); }
DI bf16x8 gfrag(const bf16* base, int ld, int row0, int k0, int lane) { return *(const bf16x8*)(base + (size_t)(row0 + (lane & 31)) * ld + k0 + 8 * (lane >> 5)); }
DI int crow(int reg, int hf) { return (reg & 3) + 8 * (reg >> 2) + 4 * hf; }
DI f32x16 zero16() { f32x16 z; for (int i = 0; i < 16; ++i) z[i] = 0.f; return z; }
DI float scan_add(float x, int lane) {
#pragma unroll
    for (int o = 1; o < 64; o <<= 1) { const float t = __shfl_up(x, o); if (lane >= o) x += t; }
    return x;
}
DI float scan_max(float x, int lane) {
#pragma unroll
    for (int o = 1; o < 64; o <<= 1) { const float t = __shfl_up(x, o); if (lane >= o) x = fmaxf(x, t); }
    return x;
}
DI u32x4 pk8(const float* v) { u32x4 w; w.x = pk2(v[0], v[1]); w.y = pk2(v[2], v[3]); w.z = pk2(v[4], v[5]); w.w = pk2(v[6], v[7]); return w; }
DI void stage_vt(const bf16* p, LAS bf16* VT, int lane) {
#pragma unroll
    for (int q = 0; q < 8; ++q) { const uint4 w = *(const uint4*)(p + 8 * q); const unsigned u[4] = {w.x, w.y, w.z, w.w};
#pragma unroll
        for (int e = 0; e < 4; ++e) { VT[(8 * q + 2 * e) * 72 + lane] = (bf16)(u[e] & 0xffffu); VT[(8 * q + 2 * e + 1) * 72 + lane] = (bf16)(u[e] >> 16); } }
}
DI void gla_logdecay(const float* w_a2, const float* b_a, int h, const bf16* p, float* la) {
    float ga[16]; ld8(p + C_GA, ga); ld8(p + C_GA + 8, ga + 8);
#pragma unroll
    for (int c = 0; c < 32; ++c) la[c] = b_a[h * 32 + c];
#pragma unroll
    for (int r = 0; r < 16; ++r)
#pragma unroll
        for (int c = 0; c < 32; ++c) la[c] += ga[r] * w_a2[r * 192 + h * 32 + c];
#pragma unroll
    for (int c = 0; c < 32; ++c) la[c] = logsigf_(la[c]) * (1.f / 16.f);
}
DI void rot_row(const bf16* p, const float2* cs, float scale, float* o) {
    float x[32];
#pragma unroll
    for (int q = 0; q < 4; ++q) ld8(p + 8 * q, x + 8 * q);
#pragma unroll
    for (int m = 0; m < 16; ++m) { const float2 c = cs[m]; o[m] = (x[m] * c.x - x[m + 16] * c.y) * scale; o[m + 16] = (x[m] * c.y + x[m + 16] * c.x) * scale; }
}

template <bool RET>
DI void gr_passA(const MixCtx& cx, int b, int h, int ch, LAS unsigned char* sl, int lane) {
    const int t = ch * 64 + lane; const size_t row = (size_t)b * SEQ + t; const bf16* p = (const bf16*)(cx.ws + WS_P) + row * DINP;
    LAS bf16* KT = (LAS bf16*)sl; LAS bf16* VT = (LAS bf16*)(sl + 9216);
    const int item = (b * 6 + h) * NCH + ch;
    float k[32];
    if (!RET) {
        float bc[32];
        gla_logdecay(cx.w_a2, cx.b_a, h, p, bc);
#pragma unroll
        for (int c = 0; c < 32; ++c) bc[c] = scan_add(bc[c], lane);
#pragma unroll
        for (int q = 0; q < 4; ++q) ld8(p + C_GK + h * 32 + 8 * q, k + 8 * q);
#pragma unroll
        for (int c = 0; c < 32; ++c) { const float bl = __shfl(bc[c], 63); k[c] *= __expf(bl - bc[c]); bc[c] = __expf(bl); }
        if (lane == 0) { float* gd = (float*)(cx.ws + ST_GDEC) + (size_t)item * 32;
#pragma unroll
            for (int q = 0; q < 8; ++q) *(f32x4*)(gd + 4 * q) = (f32x4){bc[4 * q], bc[4 * q + 1], bc[4 * q + 2], bc[4 * q + 3]}; }
    } else {
        const float lg = __logf(1.f - exp2f(-5.f - (float)h));
        rot_row(p + C_RK + h * 32, (const float2*)(cx.ws + WS_ROPE) + row * 16, QK_SCALE32 * __expf((float)(63 - lane) * lg), k);
    }
#pragma unroll
    for (int c = 0; c < 32; ++c) KT[c * 72 + lane] = f2bf(k[c]);
    stage_vt(p + (RET ? C_RV : C_GV) + h * 64, VT, lane);
    LDS_WAIT();
    f32x16 a0 = zero16(), a1 = zero16();
#pragma unroll
    for (int ks = 0; ks < 4; ++ks) { const bf16x8 bk = lfrag(KT, 72, 0, ks * 16, lane);
        a0 = mfma32(lfrag(VT, 72, 0, ks * 16, lane), bk, a0); a1 = mfma32(lfrag(VT, 72, 32, ks * 16, lane), bk, a1); }
    bf16* st = (bf16*)(cx.ws + (RET ? ST_R : ST_G)) + (size_t)item * 2048;
    const int hf = lane >> 5, r32 = lane & 31;
#pragma unroll
    for (int r = 0; r < 16; ++r) { st[crow(r, hf) * 32 + r32] = f2bf(a0[r]); st[(32 + crow(r, hf)) * 32 + r32] = f2bf(a1[r]); }
    LDS_WAIT();
}

template <bool RET>
DI void gr_passB(const MixCtx& cx, int b, int h, int ch, LAS unsigned char* sl, int lane) {
    const int t = ch * 64 + lane; const size_t row = (size_t)b * SEQ + t; const bf16* p = (const bf16*)(cx.ws + WS_P) + row * DINP;
    LAS bf16* QS = (LAS bf16*)sl; LAS bf16* KS = (LAS bf16*)(sl + 4096); LAS bf16* VT = (LAS bf16*)(sl + 9216); LAS bf16* PS = (LAS bf16*)sl; LAS float* OS = (LAS float*)sl;
    const int item = (b * 6 + h) * NCH + ch; const int hf = lane >> 5, r32 = lane & 31;
    stage_vt(p + (RET ? C_RV : C_GV) + h * 64, VT, lane);
    {
        float q[32], k[32];
        if (!RET) {
            float bc[32];
            gla_logdecay(cx.w_a2, cx.b_a, h, p, bc);
#pragma unroll
            for (int c = 0; c < 32; ++c) bc[c] = scan_add(bc[c], lane);
#pragma unroll
            for (int qq = 0; qq < 4; ++qq) { ld8(p + C_GQ + h * 32 + 8 * qq, q + 8 * qq); ld8(p + C_GK + h * 32 + 8 * qq, k + 8 * qq); }
#pragma unroll
            for (int c = 0; c < 32; ++c) { q[c] *= QK_SCALE32 * __expf(bc[c]); k[c] *= __expf(-bc[c]); }
        } else {
            const float lg = __logf(1.f - exp2f(-5.f - (float)h)); const float2* cs = (const float2*)(cx.ws + WS_ROPE) + row * 16;
            rot_row(p + C_RQ + h * 32, cs, __expf((float)(lane + 1) * lg), q);
            rot_row(p + C_RK + h * 32, cs, QK_SCALE32 * __expf(-(float)(lane + 1) * lg), k);
        }
#pragma unroll
        for (int qq = 0; qq < 4; ++qq) { *(LAS u32x4*)(QS + lane * 32 + 8 * qq) = pk8(q + 8 * qq); *(LAS u32x4*)(KS + lane * 32 + 8 * qq) = pk8(k + 8 * qq); }
    }
    LDS_WAIT();
    const bf16* st = (const bf16*)(cx.ws + (RET ? ST_R : ST_G)) + (size_t)item * 2048;
    f32x16 s00 = zero16(), s10 = zero16(), s11 = zero16();
    bf16x8 qa[2][2];
#pragma unroll
    for (int ks = 0; ks < 2; ++ks) {
        qa[0][ks] = lfrag(QS, 32, 0, ks * 16, lane); qa[1][ks] = lfrag(QS, 32, 32, ks * 16, lane);
        const bf16x8 b0 = lfrag(KS, 32, 0, ks * 16, lane), b1 = lfrag(KS, 32, 32, ks * 16, lane);
        s00 = mfma32(qa[0][ks], b0, s00); s10 = mfma32(qa[1][ks], b0, s10); s11 = mfma32(qa[1][ks], b1, s11);
    }
    LDS_WAIT();
#pragma unroll
    for (int r = 0; r < 16; ++r) { const int i0 = crow(r, hf); const bool keep = r32 <= i0;
        PS[i0 * 72 + r32] = f2bf(keep ? s00[r] : 0.f); PS[(32 + i0) * 72 + r32] = f2bf(s10[r]); PS[(32 + i0) * 72 + 32 + r32] = f2bf(keep ? s11[r] : 0.f); }
    f32x16 o00 = zero16(), o01 = zero16(), o10 = zero16(), o11 = zero16();
#pragma unroll
    for (int ks = 0; ks < 2; ++ks) { const bf16x8 g0 = gfrag(st, 32, 0, ks * 16, lane), g1 = gfrag(st, 32, 32, ks * 16, lane);
        o00 = mfma32(qa[0][ks], g0, o00); o01 = mfma32(qa[0][ks], g1, o01); o10 = mfma32(qa[1][ks], g0, o10); o11 = mfma32(qa[1][ks], g1, o11); }
    LDS_WAIT();
#pragma unroll
    for (int ks = 0; ks < 4; ++ks) { const bf16x8 v0 = lfrag(VT, 72, 0, ks * 16, lane), v1 = lfrag(VT, 72, 32, ks * 16, lane);
        if (ks < 2) { const bf16x8 a0 = lfrag(PS, 72, 0, ks * 16, lane); o00 = mfma32(a0, v0, o00); o01 = mfma32(a0, v1, o01); }
        const bf16x8 a1 = lfrag(PS, 72, 32, ks * 16, lane); o10 = mfma32(a1, v0, o10); o11 = mfma32(a1, v1, o11); }
    LDS_WAIT();
#pragma unroll
    for (int r = 0; r < 16; ++r) { const int i0 = crow(r, hf); OS[i0 * 65 + r32] = o00[r]; OS[i0 * 65 + 32 + r32] = o01[r]; OS[(32 + i0) * 65 + r32] = o10[r]; OS[(32 + i0) * 65 + 32 + r32] = o11[r]; }
    LDS_WAIT();
    float mu = 0.f, ss = 0.f;
    if (RET) { for (int c = 0; c < 64; ++c) mu += OS[lane * 65 + c]; mu *= (1.f / 64.f); }
    for (int c = 0; c < 64; ++c) { const float d = OS[lane * 65 + c] - mu; ss += d * d; }
    const float rn = rsqrtf(ss * (1.f / 64.f) + EPS);
    const float* gn = (RET ? cx.ret_gn : cx.gla_gn) + h * 64;
    const bf16* gp = p + (RET ? C_RG : C_GR) + h * 64; bf16* yp = (bf16*)(cx.ws + WS_Y) + row * D + (RET ? 384 : 0) + h * 64;
#pragma unroll
    for (int q = 0; q < 8; ++q) { float g[8], y[8]; ld8(gp + 8 * q, g);
#pragma unroll
        for (int e = 0; e < 8; ++e) y[e] = (OS[lane * 65 + 8 * q + e] - mu) * rn * gn[8 * q + e] * siluf_(g[e]);
        *(u32x4*)(yp + 8 * q) = pk8(y); }
    LDS_WAIT();
}

template <int NC>
DI void ml_conv_row(const bf16* P, size_t row, int t, int col, const float* w, int wch, float scale, float* o) {
#pragma unroll
    for (int c = 0; c < NC; ++c) o[c] = 0.f;
#pragma unroll
    for (int j = 0; j < 4; ++j) { if (t - 3 + j >= 0) { const bf16* pp = P + (row - 3 + j) * DINP + col;
#pragma unroll
            for (int q = 0; q < NC / 8; ++q) { float x[8]; ld8(pp + 8 * q, x);
#pragma unroll
                for (int e = 0; e < 8; ++e) o[8 * q + e] += w[j * 512 + wch + 8 * q + e] * x[e]; } }
        asm volatile("" ::: "memory"); }
#pragma unroll
    for (int c = 0; c < NC; ++c) o[c] = siluf_(o[c]) * scale;
}
DI void ml_passA(const MixCtx& cx, int b, int h, int ch, LAS unsigned char* sl, int lane) {
    const int t = ch * 64 + lane; const size_t row = (size_t)b * SEQ + t; const bf16* P = (const bf16*)(cx.ws + WS_P); const bf16* p = P + row * DINP;
    LAS bf16* KT = (LAS bf16*)sl; LAS bf16* VT = (LAS bf16*)(sl + 9216);
    const int item = (b * 4 + h) * NCH + ch; const int hf = lane >> 5, r32 = lane & 31;
    const float ii = bf2f(p[C_MI + h]) + cx.b_i[h];
    const float lf = logsigf_(bf2f(p[C_MF + h]) + cx.b_f[h]);
    const float bcum = scan_add(lf, lane), blast = __shfl(bcum, 63);
    const float lw = blast - bcum + ii, mloc = wave_max(lw), wgt = __expf(lw - mloc);
#pragma unroll
    for (int hh = 0; hh < 2; ++hh) {
        float k[32];
        ml_conv_row<32>(P, row, t, C_MK + h * 64 + 32 * hh, cx.conv, 256 + h * 64 + 32 * hh, 0.125f * wgt, k);
#pragma unroll
        for (int c = 0; c < 32; ++c) KT[(32 * hh + c) * 72 + lane] = f2bf(k[c]);
    }
    stage_vt(p + C_MV + h * 64, VT, lane);
    LDS_WAIT();
    f32x16 c00 = zero16(), c01 = zero16(), c10 = zero16(), c11 = zero16();
#pragma unroll
    for (int ks = 0; ks < 4; ++ks) { const bf16x8 a0 = lfrag(VT, 72, 0, ks * 16, lane), a1 = lfrag(VT, 72, 32, ks * 16, lane), b0 = lfrag(KT, 72, 0, ks * 16, lane), b1 = lfrag(KT, 72, 32, ks * 16, lane);
        c00 = mfma32(a0, b0, c00); c01 = mfma32(a0, b1, c01); c10 = mfma32(a1, b0, c10); c11 = mfma32(a1, b1, c11); }
    bf16* st = (bf16*)(cx.ws + ST_M) + (size_t)item * ML_BLK;
#pragma unroll
    for (int r = 0; r < 16; ++r) { const int v0 = crow(r, hf);
        st[v0 * 64 + r32] = f2bf(c00[r]); st[v0 * 64 + 32 + r32] = f2bf(c01[r]); st[(32 + v0) * 64 + r32] = f2bf(c10[r]); st[(32 + v0) * 64 + 32 + r32] = f2bf(c11[r]); }
    { float s = 0.f;
#pragma unroll
      for (int q = 0; q < 8; ++q) { const u32x4 w = *(const LAS u32x4*)(KT + lane * 72 + 8 * q); s += (blo(w.x) + bhi(w.x)) + (blo(w.y) + bhi(w.y)) + (blo(w.z) + bhi(w.z)) + (blo(w.w) + bhi(w.w)); }
      st[64 * 64 + lane] = f2bf(s); }
    if (lane == 0) { float* sc = (float*)(cx.ws + ST_MLSC) + (size_t)item * 4; sc[0] = blast; sc[1] = mloc; }
    LDS_WAIT();
}
DI void ml_passB(const MixCtx& cx, int b, int h, int ch, LAS unsigned char* sl, int lane) {
    const int t = ch * 64 + lane; const size_t row = (size_t)b * SEQ + t; const bf16* P = (const bf16*)(cx.ws + WS_P); const bf16* p = P + row * DINP;
    LAS bf16* R1 = (LAS bf16*)sl; LAS bf16* R2 = (LAS bf16*)(sl + 9216); LAS float* OS = (LAS float*)sl;
    const int item = (b * 4 + h) * NCH + ch; const int hf = lane >> 5, r32 = lane & 31;
    const float* cw = cx.conv;
    const bf16* st = (const bf16*)(cx.ws + ST_M) + (size_t)item * ML_BLK;
    const float mst = ((const float*)(cx.ws + ST_MLSC))[(size_t)item * 4 + 2];
    const float ii = bf2f(p[C_MI + h]) + cx.b_i[h];
    const float lf = logsigf_(bf2f(p[C_MF + h]) + cx.b_f[h]);
    const float bcum = scan_add(lf, lane);
    const float u = ii - bcum, pm = scan_max(u, lane), U = __shfl(pm, 63);
    const float mx = fmaxf(mst, pm), mi = bcum + mx, winter = __expf(mst - mx), Ai = __expf(U - mx), Bj = __expf(u - U);
    float den = 0.f;
#pragma unroll
    for (int hh = 0; hh < 2; ++hh) {
        float q[32];
        ml_conv_row<32>(P, row, t, C_MQ + h * 64 + 32 * hh, cw, h * 64 + 32 * hh, 1.f, q);
#pragma unroll
        for (int qq = 0; qq < 4; ++qq) { float n[8], a[8], w[8]; ld8(st + 64 * 64 + 32 * hh + 8 * qq, n);
#pragma unroll
            for (int e = 0; e < 8; ++e) { den += q[8 * qq + e] * n[e]; w[e] = q[8 * qq + e] * winter; a[e] = q[8 * qq + e] * Ai; }
            *(LAS u32x4*)(R1 + lane * 72 + 32 * hh + 8 * qq) = pk8(w); *(LAS u32x4*)(R2 + lane * 72 + 32 * hh + 8 * qq) = pk8(a); }
    }
    den *= winter;
    LDS_WAIT();
    bf16x8 qw[2][4];
#pragma unroll
    for (int ks = 0; ks < 4; ++ks) { qw[0][ks] = lfrag(R1, 72, 0, ks * 16, lane); qw[1][ks] = lfrag(R1, 72, 32, ks * 16, lane); }
    LDS_WAIT();
#pragma unroll
    for (int hh = 0; hh < 2; ++hh) {
        float k[32];
        ml_conv_row<32>(P, row, t, C_MK + h * 64 + 32 * hh, cw, 256 + h * 64 + 32 * hh, 0.125f * Bj, k);
#pragma unroll
        for (int qq = 0; qq < 4; ++qq) *(LAS u32x4*)(R1 + lane * 72 + 32 * hh + 8 * qq) = pk8(k + 8 * qq);
    }
    LDS_WAIT();
    f32x16 s00 = zero16(), s10 = zero16(), s11 = zero16();
#pragma unroll
    for (int ks = 0; ks < 4; ++ks) { const bf16x8 a0 = lfrag(R2, 72, 0, ks * 16, lane), a1 = lfrag(R2, 72, 32, ks * 16, lane), b0 = lfrag(R1, 72, 0, ks * 16, lane), b1 = lfrag(R1, 72, 32, ks * 16, lane);
        s00 = mfma32(a0, b0, s00); s10 = mfma32(a1, b0, s10); s11 = mfma32(a1, b1, s11); }
    LDS_WAIT();
#pragma unroll
    for (int r = 0; r < 16; ++r) { const int i0 = crow(r, hf); const bool keep = r32 <= i0;
        R1[i0 * 72 + r32] = f2bf(keep ? s00[r] : 0.f); R1[i0 * 72 + 32 + r32] = 0; R1[(32 + i0) * 72 + r32] = f2bf(s10[r]); R1[(32 + i0) * 72 + 32 + r32] = f2bf(keep ? s11[r] : 0.f); }
    f32x16 o00 = zero16(), o01 = zero16(), o10 = zero16(), o11 = zero16();
#pragma unroll
    for (int ks = 0; ks < 4; ++ks) { const bf16x8 g0 = gfrag(st, 64, 0, ks * 16, lane), g1 = gfrag(st, 64, 32, ks * 16, lane);
        o00 = mfma32(qw[0][ks], g0, o00); o01 = mfma32(qw[0][ks], g1, o01); o10 = mfma32(qw[1][ks], g0, o10); o11 = mfma32(qw[1][ks], g1, o11); }
    stage_vt(p + C_MV + h * 64, R2, lane);
    LDS_WAIT();
    { float s = 0.f;
#pragma unroll
      for (int q = 0; q < 8; ++q) { const u32x4 w = *(const LAS u32x4*)(R1 + lane * 72 + 8 * q); s += (blo(w.x) + bhi(w.x)) + (blo(w.y) + bhi(w.y)) + (blo(w.z) + bhi(w.z)) + (blo(w.w) + bhi(w.w)); }
      den += s; }
#pragma unroll
    for (int ks = 0; ks < 4; ++ks) { const bf16x8 v0 = lfrag(R2, 72, 0, ks * 16, lane), v1 = lfrag(R2, 72, 32, ks * 16, lane);
        if (ks < 2) { const bf16x8 a0 = lfrag(R1, 72, 0, ks * 16, lane); o00 = mfma32(a0, v0, o00); o01 = mfma32(a0, v1, o01); }
        const bf16x8 a1 = lfrag(R1, 72, 32, ks * 16, lane); o10 = mfma32(a1, v0, o10); o11 = mfma32(a1, v1, o11); }
    LDS_WAIT();
#pragma unroll
    for (int r = 0; r < 16; ++r) { const int i0 = crow(r, hf); OS[i0 * 65 + r32] = o00[r]; OS[i0 * 65 + 32 + r32] = o01[r]; OS[(32 + i0) * 65 + r32] = o10[r]; OS[(32 + i0) * 65 + 32 + r32] = o11[r]; }
    LDS_WAIT();
    const float inv = __builtin_amdgcn_rcpf(fmaxf(fabsf(den), __expf(-mi)));
    const bf16* gp = p + C_MO + h * 64; bf16* yp = (bf16*)(cx.ws + WS_Y) + row * D + 768 + h * 64;
#pragma unroll
    for (int q = 0; q < 8; ++q) { float g[8], y[8]; ld8(gp + 8 * q, g);
#pragma unroll
        for (int e = 0; e < 8; ++e) y[e] = OS[lane * 65 + 8 * q + e] * inv * sigmoidf_(g[e]);
        *(u32x4*)(yp + 8 * q) = pk8(y); }
    LDS_WAIT();
}

DI void mix_item(int it, int& hs, int& b, int& ch) { const int grp = it >> 4; hs = (it + (it >> 11)) & 15; b = grp & 3; ch = grp >> 2; }
DI void mix_passA(const MixCtx& cx, LAS unsigned char* sl, int gw, int ngw, int lane) {
    for (int it = gw; it < 16 * BATCH * NCH; it += ngw) { int hs, b, ch; mix_item(it, hs, b, ch); asm volatile("" : "+v"(lane));
        if (hs < 6) gr_passA<false>(cx, b, hs, ch, sl, lane); else if (hs < 12) gr_passA<true>(cx, b, hs - 6, ch, sl, lane); else ml_passA(cx, b, hs - 12, ch, sl, lane); }
}
DI void mix_passB(const MixCtx& cx, LAS unsigned char* sl, int gw, int ngw, int lane) {
    for (int it = gw; it < 16 * BATCH * NCH; it += ngw) { int hs, b, ch; mix_item(it, hs, b, ch); asm volatile("" : "+v"(lane));
        if (hs < 6) gr_passB<false>(cx, b, hs, ch, sl, lane); else if (hs < 12) gr_passB<true>(cx, b, hs - 6, ch, sl, lane); else ml_passB(cx, b, hs - 12, ch, sl, lane); }
}
DI void mix_scan(const MixCtx& cx, int gtid, int nthr) {
    constexpr int T_GR = 24 * 1024, T_ML = 16 * (ML_BLK / 2);
    for (int task = gtid; task < 2 * T_GR + T_ML; task += nthr) {
        if (task < 2 * T_GR) {
            const bool ret = task >= T_GR; const int tt = ret ? task - T_GR : task; const int seq = tt >> 10, w = tt & 1023;
            unsigned* base = (unsigned*)(cx.ws + (ret ? ST_R : ST_G)) + (size_t)seq * NCH * 1024 + w;
            const float* gd = (const float*)(cx.ws + ST_GDEC) + (size_t)seq * NCH * 32 + ((2 * w) & 31);
            const float gr = __expf(64.f * __logf(1.f - exp2f(-5.f - (float)(seq % 6))));
            float s0 = 0.f, s1 = 0.f;
            for (int c0 = 0; c0 < NCH; c0 += 8) { unsigned dv[8]; float g0[8], g1[8];
#pragma unroll
                for (int j = 0; j < 8; ++j) { dv[j] = base[(size_t)(c0 + j) * 1024]; if (ret) { g0[j] = gr; g1[j] = gr; } else { g0[j] = gd[(c0 + j) * 32]; g1[j] = gd[(c0 + j) * 32 + 1]; } }
#pragma unroll
                for (int j = 0; j < 8; ++j) { base[(size_t)(c0 + j) * 1024] = pk2(s0, s1); s0 = g0[j] * s0 + blo(dv[j]); s1 = g1[j] * s1 + bhi(dv[j]); } }
        } else {
            const int tt = task - 2 * T_GR; const int seq = tt / (ML_BLK / 2), w = tt % (ML_BLK / 2);
            unsigned* base = (unsigned*)(cx.ws + ST_M) + (size_t)seq * NCH * (ML_BLK / 2) + w; float* sc = (float*)(cx.ws + ST_MLSC) + (size_t)seq * NCH * 4;
            float m = 0.f, c0v = 0.f, c1v = 0.f;
            for (int c0 = 0; c0 < NCH; c0 += 8) { unsigned dv[8]; float bl[8], ml[8];
#pragma unroll
                for (int j = 0; j < 8; ++j) { dv[j] = base[(size_t)(c0 + j) * (ML_BLK / 2)]; bl[j] = sc[(c0 + j) * 4]; ml[j] = sc[(c0 + j) * 4 + 1]; }
#pragma unroll
                for (int j = 0; j < 8; ++j) { base[(size_t)(c0 + j) * (ML_BLK / 2)] = pk2(c0v, c1v); if (w == 0) sc[(c0 + j) * 4 + 2] = m;
                    const float mn = fmaxf(bl[j] + m, ml[j]), g = __expf(bl[j] + m - mn), s = __expf(ml[j] - mn);
                    c0v = g * c0v + s * blo(dv[j]); c1v = g * c1v + s * bhi(dv[j]); m = mn; } }
        }
    }
}

constexpr int ATT_LD = 264;
static_assert(256 * ATT_LD * 2 <= MISC_OFF, "attention image fits under the LDS control words");
typedef unsigned u32x2 __attribute__((ext_vector_type(2)));
typedef float f32x2_t __attribute__((ext_vector_type(2)));
typedef __bf16 bf16x2_t __attribute__((ext_vector_type(2)));
DI unsigned cvtpk(float lo, float hi) { const f32x2_t v = {lo, hi}; const bf16x2_t b = __builtin_convertvector(v, bf16x2_t); return __builtin_bit_cast(unsigned, b); }
DI void att_stage(const bf16* src, size_t src_pitch, LAS bf16* img, int tid) {
#pragma unroll 4
    for (int it = 0; it < 16; ++it) { const int c = tid + 512 * it, r = c >> 5, part = c & 31;
        const u32x4 v = *(const u32x4*)(src + (size_t)r * src_pitch + part * 8); *(LAS u32x4*)(img + r * ATT_LD + part * 8) = v; }
}
DI void attn_phase(unsigned char* ws, int l, LAS unsigned char* lds, int G, int tid, const int wave) {
    LAS bf16* img = (LAS bf16*)lds;
    const bf16* Q = (const bf16*)(ws + WS_Q); bf16* O = (bf16*)(ws + WS_O);
    const bf16* KBl = (const bf16*)(ws + WS_KB) + (size_t)l * 1024 * 1024; const bf16* VTl = (const bf16*)(ws + WS_VT) + (size_t)l * 4 * 1024 * 256;
    for (int u = blockIdx.x; u < BATCH * 4 * (SEQ / 256); u += G) {
        asm volatile("" : "+v"(tid)); const int lane = tid & 63, hf = lane >> 5, r32 = lane & 31;
        const int qt = u & 31, hd = (u >> 5) & 3, b = u >> 7;
        const size_t m0 = (size_t)b * SEQ + qt * 256 + wave * 32;
        att_stage(KBl + ((size_t)b * 256) * 1024 + hd * 256, 1024, img, tid);
        __syncthreads();
        f32x16 sa[8];
#pragma unroll
        for (int kt = 0; kt < 8; ++kt) sa[kt] = zero16();
        const bf16* qb = Q + m0 * D + hd * 256;
#pragma unroll 4
        for (int ks = 0; ks < 16; ++ks) { const bf16x8 qf = gfrag(qb, D, 0, ks * 16, lane);
#pragma unroll
            for (int kt = 0; kt < 8; ++kt) sa[kt] = mfma32(lfrag(img, ATT_LD, kt * 32, ks * 16, lane), qf, sa[kt]); }
        float mx = -3.0e38f;
#pragma unroll
        for (int kt = 0; kt < 8; ++kt)
#pragma unroll
            for (int r = 0; r < 16; ++r) mx = fmaxf(mx, sa[kt][r]);
        mx = fmaxf(mx, __shfl_xor(mx, 32));
        float sum = 0.f; unsigned pf[8][2][4];
#pragma unroll
        for (int kt = 0; kt < 8; ++kt) {
#pragma unroll
            for (int r = 0; r < 16; ++r) { sa[kt][r] = __expf(sa[kt][r] - mx); sum += sa[kt][r]; }
#pragma unroll
            for (int s = 0; s < 2; ++s)
#pragma unroll
                for (int j = 0; j < 4; ++j) pf[kt][s][j] = cvtpk(sa[kt][8 * s + 2 * j], sa[kt][8 * s + 2 * j + 1]); }
        sum += __shfl_xor(sum, 32);
        const float inv = __builtin_amdgcn_rcpf(sum);
        __syncthreads();
        att_stage(VTl + ((size_t)b * 1024 + hd * 256) * 256, 256, img, tid);
        __syncthreads();
        f32x16 oa[8];
#pragma unroll
        for (int vt = 0; vt < 8; ++vt) oa[vt] = zero16();
#pragma unroll
        for (int kt = 0; kt < 8; ++kt)
#pragma unroll
            for (int s = 0; s < 2; ++s) { u32x4 pa; pa.x = pf[kt][s][0]; pa.y = pf[kt][s][1]; pa.z = pf[kt][s][2]; pa.w = pf[kt][s][3];
                const bf16x8 a = __builtin_bit_cast(bf16x8, pa);
#pragma unroll
                for (int vt = 0; vt < 8; ++vt) { const LAS bf16* vp = img + (vt * 32 + r32) * ATT_LD + kt * 32 + 16 * s + 4 * hf;
                    const u32x2 lo = *(const LAS u32x2*)vp, hi = *(const LAS u32x2*)(vp + 8);
                    u32x4 bb; bb.x = lo.x; bb.y = lo.y; bb.z = hi.x; bb.w = hi.y;
                    oa[vt] = mfma32(a, __builtin_bit_cast(bf16x8, bb), oa[vt]); } }
        bf16* ob = O + m0 * D + hd * 256;
#pragma unroll
        for (int r = 0; r < 16; ++r) { const int i0 = crow(r, hf); const float sc = __shfl(inv, i0);
#pragma unroll
            for (int vt = 0; vt < 8; ++vt) ob[(size_t)i0 * D + vt * 32 + r32] = f2bf(oa[vt][r] * sc); }
        __syncthreads();
    }
}
DI void final_phase(const Args& args, int gw, int ngw, int lane) {
    const float* part = (const float*)(args.ws + WS_PART); const f32x4* g = (const f32x4*)argp(args, I_GFINAL); float* out = args.out;
    f32x4 gg[4];
#pragma unroll
    for (int j = 0; j < 4; ++j) gg[j] = g[lane + 64 * j];
    for (int m = gw; m < M; m += ngw) { const float r = row_rstd(part, m); f32x4* xr = (f32x4*)(out + (size_t)m * D);
#pragma unroll
        for (int j = 0; j < 4; ++j) { const f32x4 v = xr[lane + 64 * j]; xr[lane + 64 * j] = v * r * gg[j]; } }
}
#define IN(k) (lo <= (k) && (k) < hi)
#define SEAM(k) do { if (hi > (k) + 1) xcd_barrier(bar); } while (0)
#define WSP(T, off) ((T*)(ws + (off)))
#define PHASE_IDS() int tid = wave * 64 + lane_id(); asm volatile("" : "+v"(tid)); int lane = tid & 63
#define GEMM_SITE(EpiT, gexpr, eexpr) do { pg8::Gemm g = gexpr; pg8::StaticOrder S; S.init(g.M, g.N, G, (int)blockIdx.x); pg8::EpiT E = eexpr; pg8::gemm_phase<pg8::EpiT, pg8::StaticOrder, true, true>(lds, g, S, E, wave); } while (0)

template <int L>
DI void layer_phases(const Args& args, LAS unsigned char* lds, const XcdBarrier& bar, const int lo, const int hi, const int G, const int wave) {
    unsigned char* const ws = args.ws;
    constexpr int l = L, base = PH_L0 + L * PH_PER_LAYER;
    const int gw = blockIdx.x * NWAVES + wave, ngw = G * NWAVES;
    if (IN(base + LP_CONV)) { if (l > 0) { PHASE_IDS(); convert_layer(args, l, (LAS float*)(lds + wave * WSLICE), gw, ngw, lane); } SEAM(base + LP_CONV); }
    if (IN(base + LP_GUA)) {
        GEMM_SITE(EpiSwiglu, (pg8::Gemm{WSP(bf16, WS_XB), WSP(bf16, WS_WL + WL_GUA), M, 2 * DFF, D}), (pg8::EpiSwiglu{WSP(float, WS_PART), WSP(bf16, WS_H)}));
        SEAM(base + LP_GUA); }
    if (IN(base + LP_DNA)) {
        GEMM_SITE(EpiRes, (pg8::Gemm{WSP(bf16, WS_H), WSP(bf16, WS_WL + WL_DNA), M, D, DFF}), (pg8::EpiRes{(l == 0) ? (const float*)argp(args, I_X) : (const float*)args.out, args.out, WSP(bf16, WS_XB), WSP(float, WS_PART), 0.5f}));
        SEAM(base + LP_DNA); }
    if (IN(base + LP_WIN)) {
        GEMM_SITE(EpiScale, (pg8::Gemm{WSP(bf16, WS_XB), WSP(bf16, WS_WL + WL_IN), M, DINP, D}), (pg8::EpiScale{WSP(float, WS_PART), WSP(bf16, WS_P), DINP, 1.f}));
        SEAM(base + LP_WIN); }
    if (IN(base + LP_MIXA) || IN(base + LP_SCAN) || IN(base + LP_MIXB)) {
        MixCtx cx; cx.ws = ws; cx.w_a2 = (const float*)argp(args, I_GLAWA2) + (size_t)l * 16 * 192; cx.b_a = (const float*)argp(args, I_GLABA) + l * 192; cx.gla_gn = (const float*)argp(args, I_GLAGN) + l * 384;
        cx.ret_gn = (const float*)argp(args, I_RETGN) + l * 384; cx.conv = (const float*)argp(args, I_MLCONV) + (size_t)l * 4 * 512; cx.b_i = (const float*)argp(args, I_MLBI) + l * 4; cx.b_f = (const float*)argp(args, I_MLBF) + l * 4;
        if (IN(base + LP_MIXA)) { PHASE_IDS(); mix_passA(cx, lds + wave * WSLICE, gw, ngw, lane); SEAM(base + LP_MIXA); }
        if (IN(base + LP_SCAN)) { PHASE_IDS(); mix_scan(cx, blockIdx.x * NTHR + tid, G * NTHR); SEAM(base + LP_SCAN); }
        if (IN(base + LP_MIXB)) { PHASE_IDS(); mix_passB(cx, lds + wave * WSLICE, gw, ngw, lane); SEAM(base + LP_MIXB); }
    }
    if (IN(base + LP_WOUT)) {
        GEMM_SITE(EpiRes, (pg8::Gemm{WSP(bf16, WS_Y), WSP(bf16, WS_WL + WL_OUT), M, D, D}), (pg8::EpiRes{args.out, args.out, WSP(bf16, WS_XB), WSP(float, WS_PART), 1.0f}));
        SEAM(base + LP_WOUT); }
    if (IN(base + LP_XQ)) {
        GEMM_SITE(EpiScale, (pg8::Gemm{WSP(bf16, WS_XB), WSP(bf16, WS_WL + WL_XQ), M, D, D}), (pg8::EpiScale{WSP(float, WS_PART), WSP(bf16, WS_Q), D, 0.0625f}));
        SEAM(base + LP_XQ); }
    if (IN(base + LP_ATT)) { PHASE_IDS(); (void)lane; attn_phase(ws, l, lds, G, tid, wave); SEAM(base + LP_ATT); }
    if (IN(base + LP_XO)) {
        GEMM_SITE(EpiRes, (pg8::Gemm{WSP(bf16, WS_O), WSP(bf16, WS_WL + WL_XO), M, D, D}), (pg8::EpiRes{args.out, args.out, WSP(bf16, WS_XB), WSP(float, WS_PART), 1.0f}));
        SEAM(base + LP_XO); }
    if (IN(base + LP_GUB)) {
        GEMM_SITE(EpiSwiglu, (pg8::Gemm{WSP(bf16, WS_XB), WSP(bf16, WS_WL + WL_GUB), M, 2 * DFF, D}), (pg8::EpiSwiglu{WSP(float, WS_PART), WSP(bf16, WS_H)}));
        SEAM(base + LP_GUB); }
    if (IN(base + LP_DNB)) {
        GEMM_SITE(EpiRes, (pg8::Gemm{WSP(bf16, WS_H), WSP(bf16, WS_WL + WL_DNB), M, D, DFF}), (pg8::EpiRes{args.out, args.out, WSP(bf16, WS_XB), WSP(float, WS_PART), 0.5f}));
        SEAM(base + LP_DNB); }
}

__global__ void __launch_bounds__(NTHR, 2) fwd(Args args) {
    extern __shared__ __attribute__((aligned(16))) unsigned char lds_raw[];
    LAS unsigned char* lds = (LAS unsigned char*)lds_raw;
    const int wave = __builtin_amdgcn_readfirstlane((int)threadIdx.x >> 6);
    const int G = gridDim.x;
    unsigned char* const ws = args.ws;
    for (int u = wave * 64 + lane_id(); u < (LDS_BYTES - MISC_OFF) / 4; u += NTHR) ((LAS unsigned*)(lds + MISC_OFF))[u] = 0u;
    __syncthreads();
    const XcdBarrier bar = xcd_barrier_post((unsigned*)(ws + WS_CTL) + CW_BAR + args.li * XCD_BAR_WORDS, (volatile LAS unsigned*)(lds + MISC_OFF), wave);
    const int lo = args.ph_lo, hi = args.ph_hi;

    if (IN(PH_PRO)) { PHASE_IDS();
        const int gw = blockIdx.x * NWAVES + wave, ngw = G * NWAVES; LAS float* scr = (LAS float*)(lds + wave * WSLICE);
        convert_kv(args, scr, gw, ngw, lane);
        convert_layer(args, 0, scr, gw, ngw, lane);
        { const float* x = (const float*)argp(args, I_X); for (int m = gw; m < M; m += ngw) stats_row(x + (size_t)m * D, WSP(bf16, WS_XB) + (size_t)m * D, WSP(float, WS_PART) + (size_t)m * 16, lane); }
        { const float* mem = (const float*)argp(args, I_MEM); for (int m = gw; m < BATCH * MEMLEN; m += ngw) stats_row(mem + (size_t)m * D, WSP(bf16, WS_MEMB) + (size_t)m * D, WSP(float, WS_MEMP) + (size_t)m * 16, lane); }
        { const int* pos = (const int*)argp(args, I_POS); float2* rope = WSP(float2, WS_ROPE);
          for (int i = blockIdx.x * NTHR + tid; i < M * 16; i += G * NTHR) { const int r = i >> 4, m = i & 15;
            const float invf = 1.0f / powf(10000.0f, (float)m / 15.0f); const float ang = (float)pos[r] * invf;
            rope[i] = make_float2((float)cos((double)ang), (float)sin((double)ang)); } }
        SEAM(PH_PRO);
    }
    if (IN(PH_KV)) {
        GEMM_SITE(EpiKV, (pg8::Gemm{WSP(bf16, WS_MEMB), WSP(bf16, WS_WKV), BATCH * MEMLEN, DEPTH * 2048, D}), (pg8::EpiKV{WSP(float, WS_MEMP), WSP(bf16, WS_KB), WSP(bf16, WS_VT)}));
        SEAM(PH_KV);
    }
    layer_phases<0>(args, lds, bar, lo, hi, G, wave);
    layer_phases<1>(args, lds, bar, lo, hi, G, wave);
    layer_phases<2>(args, lds, bar, lo, hi, G, wave);
    layer_phases<3>(args, lds, bar, lo, hi, G, wave);
    if (IN(PH_FINAL)) { PHASE_IDS(); final_phase(args, blockIdx.x * NWAVES + wave, G * NWAVES, lane); }
}
#undef IN
#undef SEAM
extern "C" void kernel_launch(void* const* d_in, const int* in_sizes, int n_in, void* d_out, int out_size, void* d_ws, size_t ws_size, hipStream_t stream) {
    static int grid = 0;
    if (grid == 0) {
        if (n_in != 25 || ws_size < WS_END || out_size != M * D) { fprintf(stderr, "kernel_launch: unexpected inputs (n_in %d, ws %zu, out %d)\n", n_in, ws_size, out_size); grid = -1; return; }
        int dev = 0, cus = 0, per_cu = 0;
        if (hipGetDevice(&dev) != hipSuccess || hipDeviceGetAttribute(&cus, hipDeviceAttributeMultiprocessorCount, dev) != hipSuccess) { grid = -1; return; }
        if (hipFuncSetAttribute((const void*)fwd, hipFuncAttributeMaxDynamicSharedMemorySize, LDS_BYTES) != hipSuccess) { fprintf(stderr, "kernel_launch: hipFuncSetAttribute failed\n"); grid = -1; return; }
        if (hipOccupancyMaxActiveBlocksPerMultiprocessor(&per_cu, (const void*)fwd, NTHR, LDS_BYTES) != hipSuccess || per_cu < 1) fprintf(stderr, "kernel_launch: occupancy query says %d\n", per_cu);
        (void)hipGetLastError();
        grid = cus;
    }
    if (grid < 0) return;
    hipMemsetAsync((char*)d_ws + WS_CTL, 0, 1 * MiB, stream);
    unsigned char* ws = (unsigned char*)d_ws; float* out = (float*)d_out;
    int li = 0;
    auto launch = [&](int lo, int hi) {
        Args a{}; for (int i = 0; i < 25; ++i) a.in[i] = d_in[i];
        a.out = out; a.ws = ws; a.ph_lo = lo; a.ph_hi = hi; a.li = li++; a.pad = 0;
        hipLaunchKernelGGL(fwd, dim3(grid), dim3(NTHR), LDS_BYTES, stream, a);
    };
    launch(PH_PRO, PH_END);
}
```

```cpp
#include <hip/hip_runtime.h>
#include <cstdio>
#include <cstdint>

typedef unsigned short bf16;
typedef short bf16x8 __attribute__((ext_vector_type(8)));
typedef float f32x4 __attribute__((ext_vector_type(4)));
typedef float f32x16 __attribute__((ext_vector_type(16)));
typedef unsigned u32x4 __attribute__((ext_vector_type(4)));
#define DI __device__ __forceinline__
#define LAS __attribute__((address_space(3)))

constexpr int BATCH = 4, SEQ = 8192, D = 1024, DEPTH = 4, MEMLEN = 256;
constexpr int M = BATCH * SEQ;
constexpr int DFF = 2816, DIN = 3352, DINP = 3584;
constexpr float EPS = 1e-6f;
constexpr int C_GQ = 0, C_GK = 192, C_GV = 384, C_GA = 768, C_GR = 784, C_RQ = 1168, C_RK = 1360, C_RV = 1552, C_RG = 1936,
              C_MQ = 2320, C_MK = 2576, C_MV = 2832, C_MO = 3088, C_MI = 3344, C_MF = 3348;

constexpr size_t MiB = 1u << 20;
constexpr size_t WS_CTL = 0, WS_ROPE = 1 * MiB, WS_PART = 5 * MiB, WS_MEMB = 7 * MiB, WS_MEMP = 9 * MiB, WS_KB = 10 * MiB, WS_VT = 18 * MiB,
                 WS_WKV = 26 * MiB, WS_WL = 42 * MiB, WS_XB = 88 * MiB, WS_R = 152 * MiB,
                 WS_P = WS_R, WS_ST = 376 * MiB, WS_Y = 420 * MiB, WS_H = WS_R, WS_Q = WS_R, WS_O = 216 * MiB, WS_END = 484 * MiB;
constexpr size_t WL_GUA = 0, WL_DNA = WL_GUA + (size_t)2 * DFF * D * 2, WL_IN = WL_DNA + (size_t)D * DFF * 2, WL_OUT = WL_IN + (size_t)DINP * D * 2,
                 WL_XQ = WL_OUT + (size_t)D * D * 2, WL_XO = WL_XQ + (size_t)D * D * 2, WL_GUB = WL_XO + (size_t)D * D * 2, WL_DNB = WL_GUB + (size_t)2 * DFF * D * 2,
                 WL_END = WL_DNB + (size_t)D * DFF * 2;
static_assert(WS_WL + WL_END <= WS_XB, "per-layer weights fit");
static_assert(WS_P + (size_t)M * DINP * 2 <= WS_ST && WS_H + (size_t)M * DFF * 2 <= WS_ST && WS_Y + (size_t)M * D * 2 <= WS_END, "ws map");
constexpr int CW_BAR = 4096;

DI float bf2f(bf16 b) { return __uint_as_float(((unsigned)b) << 16); }
DI bf16 f2bf(float f) { unsigned u = __float_as_uint(f); return (bf16)((u + 0x7fffu + ((u >> 16) & 1u)) >> 16); }
typedef float f32x2_t_ __attribute__((ext_vector_type(2)));
typedef __bf16 bf16x2_t_ __attribute__((ext_vector_type(2)));
DI unsigned pk2(float lo, float hi) { const f32x2_t_ v = {lo, hi}; const bf16x2_t_ b = __builtin_convertvector(v, bf16x2_t_); return __builtin_bit_cast(unsigned, b); }
DI float sigmoidf_(float x) { return __builtin_amdgcn_rcpf(1.f + __expf(-x)); }
DI float siluf_(float x) { return x * __builtin_amdgcn_rcpf(1.f + __expf(-x)); }
DI float logsigf_(float x) { return fminf(x, 0.f) - __logf(1.f + __expf(-fabsf(x))); }
DI float wave_sum(float v) {
#pragma unroll
    for (int o = 1; o < 64; o <<= 1) v += __shfl_xor(v, o);
    return v;
}
DI float wave_max(float v) {
#pragma unroll
    for (int o = 1; o < 64; o <<= 1) v = fmaxf(v, __shfl_xor(v, o));
    return v;
}
DI float row_rstd(const float* part, int row) {
    const f32x4* p = (const f32x4*)(part + (size_t)row * 16);
    const f32x4 a = p[0], b = p[1], c = p[2], d = p[3];
    const float s = ((a.x + a.y) + (a.z + a.w)) + ((b.x + b.y) + (b.z + b.w)) + ((c.x + c.y) + (c.z + c.w)) + ((d.x + d.y) + (d.z + d.w));
    return rsqrtf(s * (1.f / D) + EPS);
}
DI int lane_id() { return (int)__builtin_amdgcn_mbcnt_hi(~0u, __builtin_amdgcn_mbcnt_lo(~0u, 0u)); }
namespace pg8 {
#define PG8_LAS __attribute__((address_space(3)))
typedef unsigned short bf16_t;
typedef short bf16x8 __attribute__((ext_vector_type(8)));
typedef float f32x4 __attribute__((ext_vector_type(4)));
typedef unsigned u32x4 __attribute__((ext_vector_type(4)));
constexpr int BM = 256, BK = 64, HALF = 128, HTB = HALF * BK * 2  , STAGE_BYTES = 8 * HTB, NXCD = 8, WGM = 8;

__host__ __device__ __forceinline__ int lds_byte(int r, int c) { const int st = (r >> 4) * 2 + (c >> 5), rr = r & 15, cc = c & 31, ob = rr * 64 + cc * 2; return st * 1024 + (ob ^ (((ob >> 9) & 1) << 5)); }
__host__ __device__ __forceinline__ void stage_rc(int b, int& R, int& C) { const int st = b / 1024, sb = b % 1024, swz = sb ^ (((sb >> 9) & 1) << 5); R = (st >> 1) * 16 + swz / 64; C = (st & 1) * 32 + (swz % 64) / 2; }
__host__ __device__ __forceinline__ int perm32(int rho) { const int n = rho >> 4, i = rho & 15; return 8 * (i >> 2) + 4 * n + (i & 3); }

struct Unit { int pm, pn; };
struct Gemm { const bf16_t* A; const bf16_t* Bt; int M, N, K; };

struct StaticOrder {
    int nM, nN, nwg, G, c;
    __host__ __device__ void init(int M, int N, int G_, int c_) { nM = M / BM; nN = N / BM; nwg = nM * nN; G = G_; c = c_; }
    __host__ __device__ bool next(int i, Unit& u) const {
        const long L = (long)i * G + c; if (L >= nwg) return false;
        int wgid = (int)L; { const int q = nwg / NXCD, r = nwg % NXCD, xcd = wgid % NXCD, off = wgid / NXCD; wgid = (xcd < r ? xcd * (q + 1) : r * (q + 1) + (xcd - r) * q) + off; }
        const int nig = WGM * nN, gid = wgid / nig, fm = gid * WGM, gsz = (nM - fm) < WGM ? (nM - fm) : WGM;
        u.pm = fm + ((wgid % nig) % gsz); u.pn = (wgid % nig) / gsz; return true;
    }
    __device__ __forceinline__ void a_ready(const Unit&) const {}
    __device__ __forceinline__ void done(const Unit&) const {}
};

__device__ __forceinline__ unsigned cvt_pk_bf16(float lo, float hi) { unsigned r; asm volatile("v_cvt_pk_bf16_f32 %0, %1, %2" : "=v"(r) : "v"(lo), "v"(hi)); return r; }
__device__ __forceinline__ u32x4 pack8(const f32x4 v0, const f32x4 v1) { u32x4 w; w.x = cvt_pk_bf16(v0[0], v0[1]); w.y = cvt_pk_bf16(v0[2], v0[3]); w.z = cvt_pk_bf16(v1[0], v1[1]); w.w = cvt_pk_bf16(v1[2], v1[3]); return w; }
__device__ __forceinline__ f32x4 silu4(const f32x4 a) { f32x4 r; r[0] = siluf_(a[0]); r[1] = siluf_(a[1]); r[2] = siluf_(a[2]); r[3] = siluf_(a[3]); return r; }

struct RstdTab { const PG8_LAS float* tab; const float* part; int g0, c7;
    __device__ __forceinline__ float get(int pm, int r) const { const int slot = (pm >> 3) - g0; return ((unsigned)slot < 4u && (pm & 7) == c7) ? tab[slot * 256 + r] : row_rstd(part, pm * BM + r); } };
struct EpiSwiglu {
    static constexpr bool PERM = true, AFTER_DRAIN = false;
    RstdTab rt; bf16_t* H;
    __device__ __forceinline__ void operator()(const f32x4 (&acc)[2][2][4][2], const Unit& u, int wr, int wc, int fr, int fq) const {
        const int r0 = wr * 64 + fr, col0 = u.pn * 128 + wc * 32 + 8 * fq;
#pragma unroll
        for (int ai = 0; ai < 2; ++ai)
#pragma unroll
            for (int m = 0; m < 4; ++m) { const int r = r0 + ai * HALF + m * 16; const float rs = rt.get(u.pm, r);
                const f32x4 a0 = acc[ai][0][m][0] * rs, a1 = acc[ai][0][m][1] * rs, g0 = acc[ai][1][m][0] * rs, g1 = acc[ai][1][m][1] * rs;
                *(u32x4*)(H + (size_t)(u.pm * BM + r) * DFF + col0) = pack8(silu4(a0) * g0, silu4(a1) * g1); }
    }
};
struct EpiRes {
    static constexpr bool PERM = true, AFTER_DRAIN = false;
    bf16_t* xb; float* part; float alpha;
    __device__ __forceinline__ void operator()(const f32x4 (&acc)[2][2][4][2], const Unit& u, int wr, int wc, int fr, int fq) const {
        const int row0 = u.pm * BM + wr * 64 + fr, col0 = u.pn * BM + wc * 32 + 8 * fq;
#pragma unroll
        for (int ai = 0; ai < 2; ++ai)
#pragma unroll
            for (int m = 0; m < 4; ++m) { const int row = row0 + ai * HALF + m * 16; bf16_t* xp = xb + (size_t)row * D + col0; float ss = 0.f;
#pragma unroll
                for (int bj = 0; bj < 2; ++bj) { const u32x4 xv = *(const u32x4*)(xp + bj * HALF);
                    const f32x4 x0 = {__uint_as_float(xv.x << 16), __uint_as_float(xv.x & 0xffff0000u), __uint_as_float(xv.y << 16), __uint_as_float(xv.y & 0xffff0000u)};
                    const f32x4 x1 = {__uint_as_float(xv.z << 16), __uint_as_float(xv.z & 0xffff0000u), __uint_as_float(xv.w << 16), __uint_as_float(xv.w & 0xffff0000u)};
                    const f32x4 y0 = x0 + acc[ai][bj][m][0] * alpha, y1 = x1 + acc[ai][bj][m][1] * alpha;
                    *(u32x4*)(xp + bj * HALF) = pack8(y0, y1);
                    ss += ((y0[0] * y0[0] + y0[1] * y0[1]) + (y0[2] * y0[2] + y0[3] * y0[3])) + ((y1[0] * y1[0] + y1[1] * y1[1]) + (y1[2] * y1[2] + y1[3] * y1[3])); }
                ss += __shfl_xor(ss, 16); ss += __shfl_xor(ss, 32);
                if (fq == 0) part[(size_t)row * 16 + u.pn * 4 + wc] = ss; }
    }
};
struct EpiScale {
    static constexpr bool PERM = true, AFTER_DRAIN = false;
    RstdTab rt; bf16_t* O; int ldc; float scale;
    __device__ __forceinline__ void operator()(const f32x4 (&acc)[2][2][4][2], const Unit& u, int wr, int wc, int fr, int fq) const {
        const int r0 = wr * 64 + fr, col0 = u.pn * BM + wc * 32 + 8 * fq;
#pragma unroll
        for (int ai = 0; ai < 2; ++ai)
#pragma unroll
            for (int m = 0; m < 4; ++m) { const int r = r0 + ai * HALF + m * 16; const float rs = rt.get(u.pm, r) * scale; bf16_t* rowp = O + (size_t)(u.pm * BM + r) * ldc + col0;
#pragma unroll
                for (int bj = 0; bj < 2; ++bj) *(u32x4*)(rowp + bj * HALF) = pack8(acc[ai][bj][m][0] * rs, acc[ai][bj][m][1] * rs); }
    }
};
struct EpiKV {
    static constexpr bool PERM = true, AFTER_DRAIN = false;
    const float* mp; bf16_t* KB; bf16_t* VT;
    __device__ __forceinline__ void operator()(const f32x4 (&acc)[2][2][4][2], const Unit& u, int wr, int wc, int fr, int fq) const {
        const int l = u.pn >> 3, pc = u.pn & 7; const int row0 = u.pm * BM + wr * 64 + fr;
#pragma unroll
        for (int ai = 0; ai < 2; ++ai)
#pragma unroll
            for (int m = 0; m < 4; ++m) { const int row = row0 + ai * HALF + m * 16; const float rs = rsqrtf(mp[(size_t)row * 16] * (1.f / D) + EPS);
#pragma unroll
                for (int bj = 0; bj < 2; ++bj) { const f32x4 v0 = acc[ai][bj][m][0] * rs, v1 = acc[ai][bj][m][1] * rs;
                    if (pc < 4) { *(u32x4*)(KB + ((size_t)l * 1024 + row) * 1024 + pc * 256 + bj * HALF + wc * 32 + 8 * fq) = pack8(v0, v1); }
                    else { const int vc = (pc - 4) * 256 + bj * HALF + wc * 32 + 8 * fq; bf16_t* vp = VT + (((size_t)l * 4 + u.pm) * 1024 + vc) * 256 + (row & 255);
#pragma unroll
                        for (int e = 0; e < 4; ++e) { vp[(size_t)e * 256] = f2bf(v0[e]); vp[(size_t)(e + 4) * 256] = f2bf(v1[e]); } } } }
    }
};
template <class Epi, class Sched, bool ALIGN_EPI = false, bool SP2 = false>
__device__ __forceinline__ void gemm_phase(PG8_LAS unsigned char* lds, const Gemm g, const Sched& S, const Epi& E, const int wave_) {
    int tid_ = wave_ * 64 + lane_id(); asm volatile("" : "+v"(tid_));
    const int tid = tid_, wid = wave_, lane = tid & 63, wr = wid >> 2, wc = wid & 3, fr = lane & 15, fq = lane >> 4;
    const int K = g.K, nt = K / BK;
    unsigned voffA[2], voffB[2];
#pragma unroll
    for (int i = 0; i < 2; ++i) { int R, C; stage_rc(tid * 16 + i * 8192, R, C); const int Rb = Epi::PERM ? ((R & ~31) + perm32(R & 31)) : R;
        voffA[i] = (unsigned)(R * K + C) * 2u; voffB[i] = (unsigned)(Rb * K + C) * 2u; }
    const size_t kstep = (size_t)(BK * 2);
    const size_t hstep = (size_t)HALF * K * 2;
    const size_t tstep = 2 * hstep;
    const unsigned ldsw = (unsigned)wid * 1024u;
    const int aoff = lds_byte(wr * 64 + fr, fq * 8), boff = lds_byte(wc * 32 + fr, fq * 8);
#define PG8_SA(b, h) (((b) * 2 + (h)) * HTB)
#define PG8_SB(b, h) ((4 + (b) * 2 + (h)) * HTB)
#define PG8_STAGE(bufoff, gbase, voff) do { _Pragma("unroll") for (int _i = 0; _i < 2; ++_i) \
        __builtin_amdgcn_global_load_lds((const unsigned*)((const char*)(gbase) + (voff)[_i]), (PG8_LAS unsigned*)(lds + (bufoff) + ldsw + _i * 8192), 16, 0, 0); } while (0)
#define PG8_LDA(dst, b, h) do { _Pragma("unroll") for (int m = 0; m < 4; ++m) _Pragma("unroll") for (int k = 0; k < 2; ++k) dst[m][k] = *(const PG8_LAS bf16x8*)(lds + PG8_SA(b, h) + aoff + m * 2048 + k * 1024); } while (0)
#define PG8_LDB(dst, b, h) do { _Pragma("unroll") for (int n = 0; n < 2; ++n) _Pragma("unroll") for (int k = 0; k < 2; ++k) dst[n][k] = *(const PG8_LAS bf16x8*)(lds + PG8_SB(b, h) + boff + n * 2048 + k * 1024); } while (0)
#define PG8_MMA(ai, bj, At, Bt) do { __builtin_amdgcn_s_setprio(1); _Pragma("unroll") for (int m = 0; m < 4; ++m) _Pragma("unroll") for (int n = 0; n < 2; ++n) _Pragma("unroll") for (int k = 0; k < 2; ++k) \
        acc[ai][bj][m][n] = __builtin_amdgcn_mfma_f32_16x16x32_bf16(Bt[n][k], At[m][k], acc[ai][bj][m][n], 0, 0, 0); __builtin_amdgcn_s_setprio(0); } while (0)
#define PG8_WAIT_V(n) asm volatile("s_waitcnt vmcnt(" #n ")" ::: "memory")
#define PG8_WAIT_L(n) asm volatile("s_waitcnt lgkmcnt(" #n ")" ::: "memory")
#define PG8_BAR __builtin_amdgcn_s_barrier()
#define PG8_SCHED __builtin_amdgcn_sched_barrier(0)
    Unit cur, nxt; int ui = 0;
    if (!S.next(0, cur)) return;
    f32x4 acc[2][2][4][2];
#pragma unroll
    for (int a = 0; a < 2; ++a)
#pragma unroll
        for (int b = 0; b < 2; ++b)
#pragma unroll
            for (int m = 0; m < 4; ++m)
#pragma unroll
                for (int n = 0; n < 2; ++n) acc[a][b][m][n] = (f32x4){0.f, 0.f, 0.f, 0.f};
    bf16x8 At[4][2], B0[2][2], B1[2][2];
    const char* cA = (const char*)g.A + (size_t)cur.pm * tstep; const char* cB = (const char*)g.Bt + (size_t)cur.pn * tstep;
    S.a_ready(cur);
    if constexpr (SP2) {
        PG8_STAGE(PG8_SB(0, 0), cB, voffB); PG8_STAGE(PG8_SB(0, 1), cB + hstep, voffB); PG8_STAGE(PG8_SA(0, 0), cA, voffA); PG8_STAGE(PG8_SA(0, 1), cA + hstep, voffA);
        if (wr == 1) PG8_BAR;
        PG8_WAIT_V(2); PG8_BAR;
        PG8_STAGE(PG8_SB(1, 0), cB + kstep, voffB); PG8_STAGE(PG8_SA(1, 0), cA + kstep, voffA); PG8_STAGE(PG8_SB(1, 1), cB + hstep + kstep, voffB);
        PG8_WAIT_V(6); PG8_BAR;
    } else {
        PG8_STAGE(PG8_SB(0, 0), cB, voffB); PG8_STAGE(PG8_SA(0, 0), cA, voffA); PG8_STAGE(PG8_SB(0, 1), cB + hstep, voffB); PG8_STAGE(PG8_SA(0, 1), cA + hstep, voffA);
        if (wr == 1) PG8_BAR;
        PG8_WAIT_V(4); PG8_BAR;
        PG8_STAGE(PG8_SB(1, 0), cB + kstep, voffB); PG8_STAGE(PG8_SA(1, 0), cA + kstep, voffA); PG8_STAGE(PG8_SB(1, 1), cB + hstep + kstep, voffB);
        PG8_WAIT_V(6); PG8_BAR;
    }
    for (;;) {
        const bool has_next = S.next(ui + 1, nxt);
        const char* nA = has_next ? (const char*)g.A + (size_t)nxt.pm * tstep : cA; const char* nB = has_next ? (const char*)g.Bt + (size_t)nxt.pn * tstep : cB;
        for (int t = 0; t < nt; t += 2) {
            const bool last = (t == nt - 2);
            const char* a1 = cA + (size_t)(t + 1) * kstep;
            const char* a2 = last ? nA : cA + (size_t)(t + 2) * kstep; const char* b2 = last ? nB : cB + (size_t)(t + 2) * kstep;
            const char* a3 = a2 + kstep; const char* b3 = b2 + kstep;
            if (last && has_next) S.a_ready(nxt);
            if constexpr (SP2) {
            PG8_LDB(B0, 0, 0); PG8_LDB(B1, 0, 1); PG8_SCHED; PG8_LDA(At, 0, 0); PG8_STAGE(PG8_SA(1, 1), a1 + hstep, voffA);
            PG8_WAIT_V(8); PG8_WAIT_L(0); PG8_BAR; PG8_MMA(0, 0, At, B0); PG8_MMA(0, 1, At, B1); PG8_BAR; PG8_SCHED;
            PG8_LDA(At, 0, 1); PG8_STAGE(PG8_SB(0, 0), b2, voffB); PG8_STAGE(PG8_SB(0, 1), b2 + hstep, voffB); PG8_STAGE(PG8_SA(0, 0), a2, voffA);
            PG8_WAIT_V(8); PG8_WAIT_L(0); PG8_BAR; PG8_MMA(1, 0, At, B0); PG8_MMA(1, 1, At, B1); PG8_BAR; PG8_SCHED;
            PG8_LDB(B0, 1, 0); PG8_LDB(B1, 1, 1); PG8_SCHED; PG8_LDA(At, 1, 0); PG8_STAGE(PG8_SA(0, 1), a2 + hstep, voffA);
            PG8_WAIT_V(8); PG8_WAIT_L(0); PG8_BAR; PG8_MMA(0, 0, At, B0); PG8_MMA(0, 1, At, B1); PG8_BAR; PG8_SCHED;
            PG8_LDA(At, 1, 1); PG8_STAGE(PG8_SB(1, 0), b3, voffB); PG8_STAGE(PG8_SB(1, 1), b3 + hstep, voffB); PG8_STAGE(PG8_SA(1, 0), a3, voffA);
            PG8_WAIT_V(8); PG8_WAIT_L(0); PG8_BAR; PG8_MMA(1, 0, At, B0); PG8_MMA(1, 1, At, B1); PG8_BAR; PG8_SCHED;
            } else {
            PG8_LDB(B0, 0, 0); PG8_SCHED; PG8_LDA(At, 0, 0); PG8_STAGE(PG8_SA(1, 1), a1 + hstep, voffA);
            PG8_WAIT_L(8); PG8_BAR; PG8_WAIT_L(0); PG8_MMA(0, 0, At, B0); PG8_BAR; PG8_SCHED;
            PG8_LDB(B1, 0, 1); PG8_STAGE(PG8_SB(0, 0), b2, voffB);
            PG8_BAR; PG8_WAIT_L(0); PG8_MMA(0, 1, At, B1); PG8_BAR;
            PG8_LDA(At, 0, 1); PG8_STAGE(PG8_SA(0, 0), a2, voffA);
            PG8_BAR; PG8_WAIT_L(0); PG8_MMA(1, 0, At, B0); PG8_BAR; PG8_SCHED;
            PG8_STAGE(PG8_SB(0, 1), b2 + hstep, voffB);
            PG8_WAIT_V(6); PG8_BAR; PG8_MMA(1, 1, At, B1); PG8_BAR;
            PG8_LDB(B0, 1, 0); PG8_SCHED; PG8_LDA(At, 1, 0); PG8_STAGE(PG8_SA(0, 1), a2 + hstep, voffA);
            PG8_WAIT_L(8); PG8_BAR; PG8_WAIT_L(0); PG8_MMA(0, 0, At, B0); PG8_BAR; PG8_SCHED;
            PG8_LDB(B1, 1, 1); PG8_STAGE(PG8_SB(1, 0), b3, voffB);
            PG8_BAR; PG8_WAIT_L(0); PG8_MMA(0, 1, At, B1); PG8_BAR;
            PG8_LDA(At, 1, 1); PG8_STAGE(PG8_SA(1, 0), a3, voffA);
            PG8_BAR; PG8_WAIT_L(0); PG8_MMA(1, 0, At, B0); PG8_BAR; PG8_SCHED;
            PG8_STAGE(PG8_SB(1, 1), b3 + hstep, voffB);
            PG8_WAIT_V(6); PG8_BAR; PG8_MMA(1, 1, At, B1); PG8_BAR;
            }
        }
        if constexpr (ALIGN_EPI) { if (wr == 0) PG8_BAR; }
        if constexpr (!Epi::AFTER_DRAIN) { E(acc, cur, wr, wc, fr, fq); S.done(cur); }
        if (!has_next) break;
#pragma unroll
        for (int a = 0; a < 2; ++a)
#pragma unroll
            for (int b = 0; b < 2; ++b)
#pragma unroll
                for (int m = 0; m < 4; ++m)
#pragma unroll
                    for (int n = 0; n < 2; ++n) acc[a][b][m][n] = (f32x4){0.f, 0.f, 0.f, 0.f};
        cur = nxt; cA = nA; cB = nB; ++ui;
        if constexpr (ALIGN_EPI) { if (wr == 1) PG8_BAR; }
    }
    PG8_WAIT_V(0);
    if constexpr (!ALIGN_EPI) { if (wr == 0) PG8_BAR; }
    PG8_BAR;
    if constexpr (Epi::AFTER_DRAIN) { E.fused(acc, cur, wr, wc, fr, fq, lds, wid, lane); S.done(cur); }
#undef PG8_SA
#undef PG8_SB
#undef PG8_STAGE
#undef PG8_LDA
#undef PG8_LDB
#undef PG8_MMA
#undef PG8_WAIT_V
#undef PG8_WAIT_L
#undef PG8_BAR
#undef PG8_SCHED
}
}
#define XB_TMO      128
#define XB_XCNT(j)  (256  + 64 * (j))
#define XB_XSUB(j)  (1280 + 64 * (j))
#define XB_XGEN(j)  (2304 + 64 * (j))
#define XB_TOP      3328
#define XB_TOPGEN   3392
#define XCD_BAR_WORDS 3456
#define XB_SPIN_CAP (1u << 18)

__device__ __forceinline__ unsigned xb_ld(unsigned* p)              { return __hip_atomic_load(p, __ATOMIC_RELAXED, __HIP_MEMORY_SCOPE_AGENT); }
__device__ __forceinline__ unsigned xb_add(unsigned* p, unsigned v) { return __hip_atomic_fetch_add(p, v, __ATOMIC_RELAXED, __HIP_MEMORY_SCOPE_AGENT); }
__device__ __forceinline__ unsigned xb_xcc_id() { return (unsigned)__builtin_amdgcn_s_getreg((3 << 11) | 20) & 0xFu; }
#define XB_SPIN(cond, bar) do { unsigned _sp = 0; while (cond) { __builtin_amdgcn_s_sleep(1); \
    if ((++_sp & 255u) == 0u) { if (xb_ld(&(bar)[XB_TMO])) break; if (_sp > XB_SPIN_CAP) { atomicAdd(&(bar)[XB_TMO], 1u); break; } } } } while (0)

struct XcdBarrier {
    int wave;
    unsigned* bar; unsigned x;
    volatile LAS unsigned* st;
};

__device__ __forceinline__ XcdBarrier xcd_barrier_post(unsigned* bar, volatile LAS unsigned* st, int wave) {
    XcdBarrier b; b.wave = wave; b.bar = bar; b.x = xb_xcc_id(); b.st = st;
    if (wave == 0 && lane_id() == 0) (void)xb_add(&bar[XB_XCNT(b.x)], 1u);
    return b;
}
__device__ __forceinline__ void xcd_barrier_complete(unsigned* bar, unsigned x, unsigned& nloc, unsigned& nx) {
    const unsigned G = gridDim.x * gridDim.y * gridDim.z;
    unsigned sum, cnt, mine, sp = 0u;
    for (;;) {
        sum = 0u; cnt = 0u; mine = 0u;
#pragma unroll
        for (unsigned j = 0; j < 16; ++j) { const unsigned c = xb_ld(&bar[XB_XCNT(j)]); sum += c; cnt += (c > 0u) ? 1u : 0u; mine = (j == x) ? c : mine; }
        if (sum == G) break;
        __builtin_amdgcn_s_sleep(1);
        if ((++sp & 255u) == 0u) { if (xb_ld(&bar[XB_TMO])) break; if (sp > XB_SPIN_CAP) { atomicAdd(&bar[XB_TMO], 1u); break; } }
    }
    nloc = mine > 0u ? mine : 1u; nx = cnt > 0u ? cnt : 1u;
}

__device__ __forceinline__ void xcd_barrier(const XcdBarrier& b) {
    asm volatile("s_waitcnt vmcnt(0)" ::: "memory");
    __syncthreads();
    if (b.wave == 0 && lane_id() == 0) {
        unsigned* bar = b.bar;
        __builtin_amdgcn_s_waitcnt(0);
        unsigned nloc = b.st[0], nx = b.st[1];
        if (nloc == 0u) { xcd_barrier_complete(bar, b.x, nloc, nx); b.st[0] = nloc; b.st[1] = nx; }
        const unsigned old = xb_add(&bar[XB_XSUB(b.x)], 1u);
        const unsigned gen = old / nloc;
        if (old + 1u == (gen + 1u) * nloc) {
            __builtin_amdgcn_fence(__ATOMIC_RELEASE, "agent");
            asm volatile("s_waitcnt vmcnt(0)" ::: "memory");
            const unsigned og = xb_add(&bar[XB_TOP], 1u);
            const unsigned tg = og / nx;
            if (og + 1u == (tg + 1u) * nx) xb_add(&bar[XB_TOPGEN], 1u);
            else XB_SPIN(xb_ld(&bar[XB_TOPGEN]) == tg, bar);
            __builtin_amdgcn_fence(__ATOMIC_ACQUIRE, "agent");
            xb_add(&bar[XB_XGEN(b.x)], 1u);
            asm volatile("s_waitcnt vmcnt(0)" ::: "memory");
        } else {
            XB_SPIN(xb_ld(&bar[XB_XGEN(b.x)]) == gen, bar);
            __builtin_amdgcn_fence(__ATOMIC_ACQUIRE, "agent");
            asm volatile("s_waitcnt vmcnt(0)" ::: "memory");
        }
    }
    __syncthreads();
}
constexpr int NWAVES = 8, NTHR = 512;
constexpr int RING_BYTES = 131072;
constexpr int WSLICE = 19456;
constexpr int MISC_OFF = NWAVES * WSLICE;
constexpr int LDS_BYTES = MISC_OFF + 512;
static_assert(MISC_OFF >= RING_BYTES && LDS_BYTES <= 163840, "LDS map");
#define LDS_WAIT() asm volatile("s_waitcnt lgkmcnt(0)" ::: "memory")
#define VM_WAIT() asm volatile("s_waitcnt vmcnt(0)" ::: "memory")

struct Args { const void* in[25]; float* out; unsigned char* ws; int ph_lo, ph_hi, li, pad; };

constexpr int PH_PRO = 0, PH_KV = 1, PH_L0 = 2, PH_PER_LAYER = 13, PH_FINAL = PH_L0 + DEPTH * PH_PER_LAYER, PH_END = PH_FINAL + 1;
enum { LP_CONV = 0, LP_GUA, LP_DNA, LP_WIN, LP_MIXA, LP_SCAN, LP_MIXB, LP_WOUT, LP_XQ, LP_ATT, LP_XO, LP_GUB, LP_DNB };

DI void conv_item(const float* W, int ldw, int K, int NP, int nvalid, int mapk, const float* gk, bf16* WT, LAS float* scr, int item, int lane) {
    const int nblk = NP / 32, kb = item / nblk, nb = item % nblk, k0 = 64 * kb, n0 = 32 * nb;
    const int np = n0 + (lane & 31);
    int src = np; bool ok = np < nvalid;
    if (mapk == 1) { const int tile = np >> 8, t = np & 255; src = (t < 128) ? (128 * tile + t) : (DFF + 128 * tile + (t - 128)); ok = true; }
#pragma unroll 8
    for (int i = 0; i < 32; ++i) { const int kk = 2 * i + (lane >> 5); float w = ok ? W[(size_t)(k0 + kk) * ldw + src] : 0.f; if (gk) w *= gk[k0 + kk]; scr[kk * 33 + (lane & 31)] = w; }
    LDS_WAIT();
    const int c = lane & 7;
#pragma unroll
    for (int j = 0; j < 4; ++j) { const int n = (lane >> 3) + 8 * j; const LAS float* s = scr + (8 * c) * 33 + n;
        u32x4 o; o.x = pk2(s[0 * 33], s[1 * 33]); o.y = pk2(s[2 * 33], s[3 * 33]); o.z = pk2(s[4 * 33], s[5 * 33]); o.w = pk2(s[6 * 33], s[7 * 33]);
        *(u32x4*)(WT + (size_t)(n0 + n) * K + k0 + 8 * c) = o; }
    LDS_WAIT();
}
DI int sel8(int j, int a0, int a1, int a2, int a3, int a4, int a5, int a6, int a7) { return j == 0 ? a0 : j == 1 ? a1 : j == 2 ? a2 : j == 3 ? a3 : j == 4 ? a4 : j == 5 ? a5 : j == 6 ? a6 : a7; }
DI const void* argp(const Args& a, int i) { asm volatile("" : "+s"(i)); return a.in[i]; }
enum { I_X = 0, I_MEM, I_POS, I_GFFA, I_WFFAGU, I_WFFADN, I_GMIX, I_WIN, I_GLAWA2, I_GLABA, I_GLAGN, I_RETGN, I_MLCONV, I_MLBI, I_MLBF, I_WOUT, I_GXA, I_GMEM, I_WXQ, I_WXKV, I_WXO, I_GFFB, I_WFFBGU, I_WFFBDN, I_GFINAL };
DI void convert_layer(const Args& args, int l, LAS float* scr, int gw, int ngw, int lane) {
    constexpr int C_GU = (D / 64) * (2 * DFF / 32), C_DN = (DFF / 64) * (D / 32), C_IN = (D / 64) * (DINP / 32), C_SQ = (D / 64) * (D / 32);
    constexpr int NITEMS = 2 * C_GU + 2 * C_DN + C_IN + 3 * C_SQ;
    constexpr int cnt[8] = {C_GU, C_GU, C_DN, C_DN, C_IN, C_SQ, C_SQ, C_SQ};
    for (int it = gw; it < NITEMS; it += ngw) {
        int r = it, j = 0;
#pragma unroll
        for (int q = 0; q < 7; ++q) { if (j == q && r >= cnt[q]) { r -= cnt[q]; j = q + 1; } }
        const int in_idx = sel8(j, I_WFFAGU, I_WFFBGU, I_WFFADN, I_WFFBDN, I_WIN, I_WOUT, I_WXQ, I_WXO);
        const int g_idx = sel8(j, I_GFFA, I_GFFB, -1, -1, I_GMIX, -1, I_GXA, -1);
        const int ldw = sel8(j, 2 * DFF, 2 * DFF, D, D, DIN, D, D, D), K = sel8(j, D, D, DFF, DFF, D, D, D, D), NP = sel8(j, 2 * DFF, 2 * DFF, D, D, DINP, D, D, D);
        const int mapk = j < 2 ? 1 : 0;
        const size_t dst = j == 0 ? WL_GUA : j == 1 ? WL_GUB : j == 2 ? WL_DNA : j == 3 ? WL_DNB : j == 4 ? WL_IN : j == 5 ? WL_OUT : j == 6 ? WL_XQ : WL_XO;
        const float* W = (const float*)args.in[in_idx] + (size_t)l * K * ldw;
        const float* gk = g_idx >= 0 ? (const float*)args.in[g_idx >= 0 ? g_idx : 0] + l * D : nullptr;
        conv_item(W, ldw, K, NP, ldw, mapk, gk, (bf16*)(args.ws + WS_WL + dst), scr, r, lane);
    }
}
DI void convert_kv(const Args& args, LAS float* scr, int gw, int ngw, int lane) {
    constexpr int C_KV = (D / 64) * (2048 / 32);
    const float* wkv = (const float*)argp(args, I_WXKV); const float* gm = (const float*)argp(args, I_GMEM);
    for (int it = gw; it < DEPTH * C_KV; it += ngw) { const int l = it / C_KV, r = it % C_KV;
        conv_item(wkv + (size_t)l * D * 2048, 2048, D, 2048, 2048, 0, gm + l * D, (bf16*)(args.ws + WS_WKV) + (size_t)l * 2048 * D, scr, r, lane); }
}
DI void stats_row(const float* xrow, bf16* xbrow, float* prow, int lane) {
    const f32x4* xr = (const f32x4*)xrow; float s = 0.f;
#pragma unroll
    for (int j = 0; j < 4; ++j) { const f32x4 v = xr[lane + 64 * j]; s += (v.x * v.x + v.y * v.y) + (v.z * v.z + v.w * v.w);
        uint2 o; o.x = pk2(v.x, v.y); o.y = pk2(v.z, v.w); *(uint2*)(xbrow + (lane + 64 * j) * 4) = o; }
    s = wave_sum(s);
    if (lane < 16) prow[lane] = (lane == 0) ? s : 0.f;
}
struct MixCtx { unsigned char* ws; const float *w_a2, *b_a, *gla_gn, *ret_gn, *conv, *b_i, *b_f; };
constexpr int NCH = SEQ / 64;
constexpr size_t ST_G = WS_ST, ST_R = WS_ST + 12 * MiB, ST_M = WS_ST + 24 * MiB, ST_GDEC = WS_ST + 41 * MiB, ST_MLSC = WS_ST + 42 * MiB;
constexpr int ML_BLK = 65 * 64;
static_assert(ST_M + (size_t)16 * NCH * ML_BLK * 2 <= ST_GDEC && ST_MLSC + (size_t)16 * NCH * 16 <= WS_Y, "state map");
constexpr float QK_SCALE32 = 0.17677669529663687f;

DI float blo(unsigned u) { return __uint_as_float(u << 16); }
DI float bhi(unsigned u) { return __uint_as_float(u & 0xffff0000u); }
DI void ld8(const bf16* p, float* o) { const uint4 v = *(const uint4*)p; o[0] = blo(v.x); o[1] = bhi(v.x); o[2] = blo(v.y); o[3] = bhi(v.y); o[4] = blo(v.z); o[5] = bhi(v.z); o[6] = blo(v.w); o[7] = bhi(v.w); }
DI f32x16 mfma32(bf16x8 a, bf16x8 b, f32x16 c) { return __builtin_amdgcn_mfma_f32_32x32x16_bf16(a, b, c, 0, 0, 0); }
DI bf16x8 lfrag(const LAS bf16* base, int ld, int row0, int k0, int lane) { return *(const LAS bf16x8*)(base + (row0 + (lane & 31)) * ld + k0 + 8 * (lane >> 5)); }
DI bf16x8 gfrag(const bf16* base, int ld, int row0, int k0, int lane) { return *(const bf16x8*)(base + (size_t)(row0 + (lane & 31)) * ld + k0 + 8 * (lane >> 5)); }
DI int crow(int reg, int hf) { return (reg & 3) + 8 * (reg >> 2) + 4 * hf; }
DI f32x16 zero16() { f32x16 z; for (int i = 0; i < 16; ++i) z[i] = 0.f; return z; }
DI float scan_add(float x, int lane) {
#pragma unroll
    for (int o = 1; o < 64; o <<= 1) { const float t = __shfl_up(x, o); if (lane >= o) x += t; }
    return x;
}
DI float scan_max(float x, int lane) {
#pragma unroll
    for (int o = 1; o < 64; o <<= 1) { const float t = __shfl_up(x, o); if (lane >= o) x = fmaxf(x, t); }
    return x;
}
DI u32x4 pk8(const float* v) { u32x4 w; w.x = pk2(v[0], v[1]); w.y = pk2(v[2], v[3]); w.z = pk2(v[4], v[5]); w.w = pk2(v[6], v[7]); return w; }
DI void stage_vt(const bf16* p, LAS bf16* VT, int lane) {
#pragma unroll
    for (int q = 0; q < 8; ++q) { const uint4 w = *(const uint4*)(p + 8 * q); const unsigned u[4] = {w.x, w.y, w.z, w.w};
#pragma unroll
        for (int e = 0; e < 4; ++e) { VT[(8 * q + 2 * e) * 72 + lane] = (bf16)(u[e] & 0xffffu); VT[(8 * q + 2 * e + 1) * 72 + lane] = (bf16)(u[e] >> 16); } }
}
DI void gla_logdecay(const float* w_a2, const float* b_a, int h, const bf16* p, float* la) {
    float ga[16]; ld8(p + C_GA, ga); ld8(p + C_GA + 8, ga + 8);
#pragma unroll
    for (int c = 0; c < 32; ++c) la[c] = b_a[h * 32 + c];
#pragma unroll
    for (int r = 0; r < 16; ++r)
#pragma unroll
        for (int c = 0; c < 32; ++c) la[c] += ga[r] * w_a2[r * 192 + h * 32 + c];
#pragma unroll
    for (int c = 0; c < 32; ++c) la[c] = logsigf_(la[c]) * (1.f / 16.f);
}
DI void rot_row(const bf16* p, const float2* cs, float scale, float* o) {
    float x[32];
#pragma unroll
    for (int q = 0; q < 4; ++q) ld8(p + 8 * q, x + 8 * q);
#pragma unroll
    for (int m = 0; m < 16; ++m) { const float2 c = cs[m]; o[m] = (x[m] * c.x - x[m + 16] * c.y) * scale; o[m + 16] = (x[m] * c.y + x[m + 16] * c.x) * scale; }
}

template <bool RET>
DI void gr_passA(const MixCtx& cx, int b, int h, int ch, LAS unsigned char* sl, int lane) {
    const int t = ch * 64 + lane; const size_t row = (size_t)b * SEQ + t; const bf16* p = (const bf16*)(cx.ws + WS_P) + row * DINP;
    LAS bf16* KT = (LAS bf16*)sl; LAS bf16* VT = (LAS bf16*)(sl + 9216);
    const int item = (b * 6 + h) * NCH + ch;
    float k[32];
    if (!RET) {
        float bc[32];
        gla_logdecay(cx.w_a2, cx.b_a, h, p, bc);
#pragma unroll
        for (int c = 0; c < 32; ++c) bc[c] = scan_add(bc[c], lane);
#pragma unroll
        for (int q = 0; q < 4; ++q) ld8(p + C_GK + h * 32 + 8 * q, k + 8 * q);
#pragma unroll
        for (int c = 0; c < 32; ++c) { const float bl = __shfl(bc[c], 63); k[c] *= __expf(bl - bc[c]); bc[c] = __expf(bl); }
        if (lane == 0) { float* gd = (float*)(cx.ws + ST_GDEC) + (size_t)item * 32;
#pragma unroll
            for (int q = 0; q < 8; ++q) *(f32x4*)(gd + 4 * q) = (f32x4){bc[4 * q], bc[4 * q + 1], bc[4 * q + 2], bc[4 * q + 3]}; }
    } else {
        const float lg = __logf(1.f - exp2f(-5.f - (float)h));
        rot_row(p + C_RK + h * 32, (const float2*)(cx.ws + WS_ROPE) + row * 16, QK_SCALE32 * __expf((float)(63 - lane) * lg), k);
    }
#pragma unroll
    for (int c = 0; c < 32; ++c) KT[c * 72 + lane] = f2bf(k[c]);
    stage_vt(p + (RET ? C_RV : C_GV) + h * 64, VT, lane);
    LDS_WAIT();
    f32x16 a0 = zero16(), a1 = zero16();
#pragma unroll
    for (int ks = 0; ks < 4; ++ks) { const bf16x8 bk = lfrag(KT, 72, 0, ks * 16, lane);
        a0 = mfma32(lfrag(VT, 72, 0, ks * 16, lane), bk, a0); a1 = mfma32(lfrag(VT, 72, 32, ks * 16, lane), bk, a1); }
    bf16* st = (bf16*)(cx.ws + (RET ? ST_R : ST_G)) + (size_t)item * 2048;
    const int hf = lane >> 5, r32 = lane & 31;
#pragma unroll
    for (int r = 0; r < 16; ++r) { st[crow(r, hf) * 32 + r32] = f2bf(a0[r]); st[(32 + crow(r, hf)) * 32 + r32] = f2bf(a1[r]); }
    LDS_WAIT();
}

template <bool RET>
DI void gr_passB(const MixCtx& cx, int b, int h, int ch, LAS unsigned char* sl, int lane) {
    const int t = ch * 64 + lane; const size_t row = (size_t)b * SEQ + t; const bf16* p = (const bf16*)(cx.ws + WS_P) + row * DINP;
    LAS bf16* QS = (LAS bf16*)sl; LAS bf16* KS = (LAS bf16*)(sl + 4096); LAS bf16* VT = (LAS bf16*)(sl + 9216); LAS bf16* PS = (LAS bf16*)sl; LAS float* OS = (LAS float*)sl;
    const int item = (b * 6 + h) * NCH + ch; const int hf = lane >> 5, r32 = lane & 31;
    stage_vt(p + (RET ? C_RV : C_GV) + h * 64, VT, lane);
    {
        float q[32], k[32];
        if (!RET) {
            float bc[32];
            gla_logdecay(cx.w_a2, cx.b_a, h, p, bc);
#pragma unroll
            for (int c = 0; c < 32; ++c) bc[c] = scan_add(bc[c], lane);
#pragma unroll
            for (int qq = 0; qq < 4; ++qq) { ld8(p + C_GQ + h * 32 + 8 * qq, q + 8 * qq); ld8(p + C_GK + h * 32 + 8 * qq, k + 8 * qq); }
#pragma unroll
            for (int c = 0; c < 32; ++c) { q[c] *= QK_SCALE32 * __expf(bc[c]); k[c] *= __expf(-bc[c]); }
        } else {
            const float lg = __logf(1.f - exp2f(-5.f - (float)h)); const float2* cs = (const float2*)(cx.ws + WS_ROPE) + row * 16;
            rot_row(p + C_RQ + h * 32, cs, __expf((float)(lane + 1) * lg), q);
            rot_row(p + C_RK + h * 32, cs, QK_SCALE32 * __expf(-(float)(lane + 1) * lg), k);
        }
#pragma unroll
        for (int qq = 0; qq < 4; ++qq) { *(LAS u32x4*)(QS + lane * 32 + 8 * qq) = pk8(q + 8 * qq); *(LAS u32x4*)(KS + lane * 32 + 8 * qq) = pk8(k + 8 * qq); }
    }
    LDS_WAIT();
    const bf16* st = (const bf16*)(cx.ws + (RET ? ST_R : ST_G)) + (size_t)item * 2048;
    f32x16 s00 = zero16(), s10 = zero16(), s11 = zero16();
    bf16x8 qa[2][2];
#pragma unroll
    for (int ks = 0; ks < 2; ++ks) {
        qa[0][ks] = lfrag(QS, 32, 0, ks * 16, lane); qa[1][ks] = lfrag(QS, 32, 32, ks * 16, lane);
        const bf16x8 b0 = lfrag(KS, 32, 0, ks * 16, lane), b1 = lfrag(KS, 32, 32, ks * 16, lane);
        s00 = mfma32(qa[0][ks], b0, s00); s10 = mfma32(qa[1][ks], b0, s10); s11 = mfma32(qa[1][ks], b1, s11);
    }
    LDS_WAIT();
#pragma unroll
    for (int r = 0; r < 16; ++r) { const int i0 = crow(r, hf); const bool keep = r32 <= i0;
        PS[i0 * 72 + r32] = f2bf(keep ? s00[r] : 0.f); PS[(32 + i0) * 72 + r32] = f2bf(s10[r]); PS[(32 + i0) * 72 + 32 + r32] = f2bf(keep ? s11[r] : 0.f); }
    f32x16 o00 = zero16(), o01 = zero16(), o10 = zero16(), o11 = zero16();
#pragma unroll
    for (int ks = 0; ks < 2; ++ks) { const bf16x8 g0 = gfrag(st, 32, 0, ks * 16, lane), g1 = gfrag(st, 32, 32, ks * 16, lane);
        o00 = mfma32(qa[0][ks], g0, o00); o01 = mfma32(qa[0][ks], g1, o01); o10 = mfma32(qa[1][ks], g0, o10); o11 = mfma32(qa[1][ks], g1, o11); }
    LDS_WAIT();
#pragma unroll
    for (int ks = 0; ks < 4; ++ks) { const bf16x8 v0 = lfrag(VT, 72, 0, ks * 16, lane), v1 = lfrag(VT, 72, 32, ks * 16, lane);
        if (ks < 2) { const bf16x8 a0 = lfrag(PS, 72, 0, ks * 16, lane); o00 = mfma32(a0, v0, o00); o01 = mfma32(a0, v1, o01); }
        const bf16x8 a1 = lfrag(PS, 72, 32, ks * 16, lane); o10 = mfma32(a1, v0, o10); o11 = mfma32(a1, v1, o11); }
    LDS_WAIT();
#pragma unroll
    for (int r = 0; r < 16; ++r) { const int i0 = crow(r, hf); OS[i0 * 65 + r32] = o00[r]; OS[i0 * 65 + 32 + r32] = o01[r]; OS[(32 + i0) * 65 + r32] = o10[r]; OS[(32 + i0) * 65 + 32 + r32] = o11[r]; }
    LDS_WAIT();
    float mu = 0.f, ss = 0.f;
    if (RET) { for (int c = 0; c < 64; ++c) mu += OS[lane * 65 + c]; mu *= (1.f / 64.f); }
    for (int c = 0; c < 64; ++c) { const float d = OS[lane * 65 + c] - mu; ss += d * d; }
    const float rn = rsqrtf(ss * (1.f / 64.f) + EPS);
    const float* gn = (RET ? cx.ret_gn : cx.gla_gn) + h * 64;
    const bf16* gp = p + (RET ? C_RG : C_GR) + h * 64; bf16* yp = (bf16*)(cx.ws + WS_Y) + row * D + (RET ? 384 : 0) + h * 64;
#pragma unroll
    for (int q = 0; q < 8; ++q) { float g[8], y[8]; ld8(gp + 8 * q, g);
#pragma unroll
        for (int e = 0; e < 8; ++e) y[e] = (OS[lane * 65 + 8 * q + e] - mu) * rn * gn[8 * q + e] * siluf_(g[e]);
        *(u32x4*)(yp + 8 * q) = pk8(y); }
    LDS_WAIT();
}

template <int NC>
DI void ml_conv_row(const bf16* P, size_t row, int t, int col, const float* w, int wch, float scale, float* o) {
#pragma unroll
    for (int c = 0; c < NC; ++c) o[c] = 0.f;
#pragma unroll
    for (int j = 0; j < 4; ++j) { if (t - 3 + j >= 0) { const bf16* pp = P + (row - 3 + j) * DINP + col;
#pragma unroll
            for (int q = 0; q < NC / 8; ++q) { float x[8]; ld8(pp + 8 * q, x);
#pragma unroll
                for (int e = 0; e < 8; ++e) o[8 * q + e] += w[j * 512 + wch + 8 * q + e] * x[e]; } }
        asm volatile("" ::: "memory"); }
#pragma unroll
    for (int c = 0; c < NC; ++c) o[c] = siluf_(o[c]) * scale;
}
DI void ml_passA(const MixCtx& cx, int b, int h, int ch, LAS unsigned char* sl, int lane) {
    const int t = ch * 64 + lane; const size_t row = (size_t)b * SEQ + t; const bf16* P = (const bf16*)(cx.ws + WS_P); const bf16* p = P + row * DINP;
    LAS bf16* KT = (LAS bf16*)sl; LAS bf16* VT = (LAS bf16*)(sl + 9216);
    const int item = (b * 4 + h) * NCH + ch; const int hf = lane >> 5, r32 = lane & 31;
    const float ii = bf2f(p[C_MI + h]) + cx.b_i[h];
    const float lf = logsigf_(bf2f(p[C_MF + h]) + cx.b_f[h]);
    const float bcum = scan_add(lf, lane), blast = __shfl(bcum, 63);
    const float lw = blast - bcum + ii, mloc = wave_max(lw), wgt = __expf(lw - mloc);
#pragma unroll
    for (int hh = 0; hh < 2; ++hh) {
        float k[32];
        ml_conv_row<32>(P, row, t, C_MK + h * 64 + 32 * hh, cx.conv, 256 + h * 64 + 32 * hh, 0.125f * wgt, k);
#pragma unroll
        for (int c = 0; c < 32; ++c) KT[(32 * hh + c) * 72 + lane] = f2bf(k[c]);
    }
    stage_vt(p + C_MV + h * 64, VT, lane);
    LDS_WAIT();
    f32x16 c00 = zero16(), c01 = zero16(), c10 = zero16(), c11 = zero16();
#pragma unroll
    for (int ks = 0; ks < 4; ++ks) { const bf16x8 a0 = lfrag(VT, 72, 0, ks * 16, lane), a1 = lfrag(VT, 72, 32, ks * 16, lane), b0 = lfrag(KT, 72, 0, ks * 16, lane), b1 = lfrag(KT, 72, 32, ks * 16, lane);
        c00 = mfma32(a0, b0, c00); c01 = mfma32(a0, b1, c01); c10 = mfma32(a1, b0, c10); c11 = mfma32(a1, b1, c11); }
    bf16* st = (bf16*)(cx.ws + ST_M) + (size_t)item * ML_BLK;
#pragma unroll
    for (int r = 0; r < 16; ++r) { const int v0 = crow(r, hf);
        st[v0 * 64 + r32] = f2bf(c00[r]); st[v0 * 64 + 32 + r32] = f2bf(c01[r]); st[(32 + v0) * 64 + r32] = f2bf(c10[r]); st[(32 + v0) * 64 + 32 + r32] = f2bf(c11[r]); }
    { float s = 0.f;
#pragma unroll
      for (int q = 0; q < 8; ++q) { const u32x4 w = *(const LAS u32x4*)(KT + lane * 72 + 8 * q); s += (blo(w.x) + bhi(w.x)) + (blo(w.y) + bhi(w.y)) + (blo(w.z) + bhi(w.z)) + (blo(w.w) + bhi(w.w)); }
      st[64 * 64 + lane] = f2bf(s); }
    if (lane == 0) { float* sc = (float*)(cx.ws + ST_MLSC) + (size_t)item * 4; sc[0] = blast; sc[1] = mloc; }
    LDS_WAIT();
}
DI void ml_passB(const MixCtx& cx, int b, int h, int ch, LAS unsigned char* sl, int lane) {
    const int t = ch * 64 + lane; const size_t row = (size_t)b * SEQ + t; const bf16* P = (const bf16*)(cx.ws + WS_P); const bf16* p = P + row * DINP;
    LAS bf16* R1 = (LAS bf16*)sl; LAS bf16* R2 = (LAS bf16*)(sl + 9216); LAS float* OS = (LAS float*)sl;
    const int item = (b * 4 + h) * NCH + ch; const int hf = lane >> 5, r32 = lane & 31;
    const float* cw = cx.conv;
    const bf16* st = (const bf16*)(cx.ws + ST_M) + (size_t)item * ML_BLK;
    const float mst = ((const float*)(cx.ws + ST_MLSC))[(size_t)item * 4 + 2];
    const float ii = bf2f(p[C_MI + h]) + cx.b_i[h];
    const float lf = logsigf_(bf2f(p[C_MF + h]) + cx.b_f[h]);
    const float bcum = scan_add(lf, lane);
    const float u = ii - bcum, pm = scan_max(u, lane), U = __shfl(pm, 63);
    const float mx = fmaxf(mst, pm), mi = bcum + mx, winter = __expf(mst - mx), Ai = __expf(U - mx), Bj = __expf(u - U);
    float den = 0.f;
#pragma unroll
    for (int hh = 0; hh < 2; ++hh) {
        float q[32];
        ml_conv_row<32>(P, row, t, C_MQ + h * 64 + 32 * hh, cw, h * 64 + 32 * hh, 1.f, q);
#pragma unroll
        for (int qq = 0; qq < 4; ++qq) { float n[8], a[8], w[8]; ld8(st + 64 * 64 + 32 * hh + 8 * qq, n);
#pragma unroll
            for (int e = 0; e < 8; ++e) { den += q[8 * qq + e] * n[e]; w[e] = q[8 * qq + e] * winter; a[e] = q[8 * qq + e] * Ai; }
            *(LAS u32x4*)(R1 + lane * 72 + 32 * hh + 8 * qq) = pk8(w); *(LAS u32x4*)(R2 + lane * 72 + 32 * hh + 8 * qq) = pk8(a); }
    }
    den *= winter;
    LDS_WAIT();
    bf16x8 qw[2][4];
#pragma unroll
    for (int ks = 0; ks < 4; ++ks) { qw[0][ks] = lfrag(R1, 72, 0, ks * 16, lane); qw[1][ks] = lfrag(R1, 72, 32, ks * 16, lane); }
    LDS_WAIT();
#pragma unroll
    for (int hh = 0; hh < 2; ++hh) {
        float k[32];
        ml_conv_row<32>(P, row, t, C_MK + h * 64 + 32 * hh, cw, 256 + h * 64 + 32 * hh, 0.125f * Bj, k);
#pragma unroll
        for (int qq = 0; qq < 4; ++qq) *(LAS u32x4*)(R1 + lane * 72 + 32 * hh + 8 * qq) = pk8(k + 8 * qq);
    }
    LDS_WAIT();
    f32x16 s00 = zero16(), s10 = zero16(), s11 = zero16();
#pragma unroll
    for (int ks = 0; ks < 4; ++ks) { const bf16x8 a0 = lfrag(R2, 72, 0, ks * 16, lane), a1 = lfrag(R2, 72, 32, ks * 16, lane), b0 = lfrag(R1, 72, 0, ks * 16, lane), b1 = lfrag(R1, 72, 32, ks * 16, lane);
        s00 = mfma32(a0, b0, s00); s10 = mfma32(a1, b0, s10); s11 = mfma32(a1, b1, s11); }
    LDS_WAIT();
#pragma unroll
    for (int r = 0; r < 16; ++r) { const int i0 = crow(r, hf); const bool keep = r32 <= i0;
        R1[i0 * 72 + r32] = f2bf(keep ? s00[r] : 0.f); R1[i0 * 72 + 32 + r32] = 0; R1[(32 + i0) * 72 + r32] = f2bf(s10[r]); R1[(32 + i0) * 72 + 32 + r32] = f2bf(keep ? s11[r] : 0.f); }
    f32x16 o00 = zero16(), o01 = zero16(), o10 = zero16(), o11 = zero16();
#pragma unroll
    for (int ks = 0; ks < 4; ++ks) { const bf16x8 g0 = gfrag(st, 64, 0, ks * 16, lane), g1 = gfrag(st, 64, 32, ks * 16, lane);
        o00 = mfma32(qw[0][ks], g0, o00); o01 = mfma32(qw[0][ks], g1, o01); o10 = mfma32(qw[1][ks], g0, o10); o11 = mfma32(qw[1][ks], g1, o11); }
    stage_vt(p + C_MV + h * 64, R2, lane);
    LDS_WAIT();
    { float s = 0.f;
#pragma unroll
      for (int q = 0; q < 8; ++q) { const u32x4 w = *(const LAS u32x4*)(R1 + lane * 72 + 8 * q); s += (blo(w.x) + bhi(w.x)) + (blo(w.y) + bhi(w.y)) + (blo(w.z) + bhi(w.z)) + (blo(w.w) + bhi(w.w)); }
      den += s; }
#pragma unroll
    for (int ks = 0; ks < 4; ++ks) { const bf16x8 v0 = lfrag(R2, 72, 0, ks * 16, lane), v1 = lfrag(R2, 72, 32, ks * 16, lane);
        if (ks < 2) { const bf16x8 a0 = lfrag(R1, 72, 0, ks * 16, lane); o00 = mfma32(a0, v0, o00); o01 = mfma32(a0, v1, o01); }
        const bf16x8 a1 = lfrag(R1, 72, 32, ks * 16, lane); o10 = mfma32(a1, v0, o10); o11 = mfma32(a1, v1, o11); }
    LDS_WAIT();
#pragma unroll
    for (int r = 0; r < 16; ++r) { const int i0 = crow(r, hf); OS[i0 * 65 + r32] = o00[r]; OS[i0 * 65 + 32 + r32] = o01[r]; OS[(32 + i0) * 65 + r32] = o10[r]; OS[(32 + i0) * 65 + 32 + r32] = o11[r]; }
    LDS_WAIT();
    const float inv = __builtin_amdgcn_rcpf(fmaxf(fabsf(den), __expf(-mi)));
    const bf16* gp = p + C_MO + h * 64; bf16* yp = (bf16*)(cx.ws + WS_Y) + row * D + 768 + h * 64;
#pragma unroll
    for (int q = 0; q < 8; ++q) { float g[8], y[8]; ld8(gp + 8 * q, g);
#pragma unroll
        for (int e = 0; e < 8; ++e) y[e] = OS[lane * 65 + 8 * q + e] * inv * sigmoidf_(g[e]);
        *(u32x4*)(yp + 8 * q) = pk8(y); }
    LDS_WAIT();
}

DI void mix_item(int it, int& hs, int& b, int& ch) { const int grp = it >> 4; hs = (it + (it >> 11)) & 15; b = grp & 3; ch = grp >> 2; }
DI void mix_passA(const MixCtx& cx, LAS unsigned char* sl, int gw, int ngw, int lane) {
    for (int it = gw; it < 16 * BATCH * NCH; it += ngw) { int hs, b, ch; mix_item(it, hs, b, ch); asm volatile("" : "+v"(lane));
        if (hs < 6) gr_passA<false>(cx, b, hs, ch, sl, lane); else if (hs < 12) gr_passA<true>(cx, b, hs - 6, ch, sl, lane); else ml_passA(cx, b, hs - 12, ch, sl, lane); }
}
DI void mix_passB(const MixCtx& cx, LAS unsigned char* sl, int gw, int ngw, int lane) {
    for (int it = gw; it < 16 * BATCH * NCH; it += ngw) { int hs, b, ch; mix_item(it, hs, b, ch); asm volatile("" : "+v"(lane));
        if (hs < 6) gr_passB<false>(cx, b, hs, ch, sl, lane); else if (hs < 12) gr_passB<true>(cx, b, hs - 6, ch, sl, lane); else ml_passB(cx, b, hs - 12, ch, sl, lane); }
}
DI void mix_scan(const MixCtx& cx, int gtid, int nthr) {
    constexpr int T_GR = 24 * 1024, T_ML = 16 * (ML_BLK / 2);
    for (int task = gtid; task < 2 * T_GR + T_ML; task += nthr) {
        if (task < 2 * T_GR) {
            const bool ret = task >= T_GR; const int tt = ret ? task - T_GR : task; const int seq = tt >> 10, w = tt & 1023;
            unsigned* base = (unsigned*)(cx.ws + (ret ? ST_R : ST_G)) + (size_t)seq * NCH * 1024 + w;
            const float* gd = (const float*)(cx.ws + ST_GDEC) + (size_t)seq * NCH * 32 + ((2 * w) & 31);
            const float gr = __expf(64.f * __logf(1.f - exp2f(-5.f - (float)(seq % 6))));
            float s0 = 0.f, s1 = 0.f;
            for (int c0 = 0; c0 < NCH; c0 += 8) { unsigned dv[8]; float g0[8], g1[8];
#pragma unroll
                for (int j = 0; j < 8; ++j) { dv[j] = base[(size_t)(c0 + j) * 1024]; if (ret) { g0[j] = gr; g1[j] = gr; } else { g0[j] = gd[(c0 + j) * 32]; g1[j] = gd[(c0 + j) * 32 + 1]; } }
#pragma unroll
                for (int j = 0; j < 8; ++j) { base[(size_t)(c0 + j) * 1024] = pk2(s0, s1); s0 = g0[j] * s0 + blo(dv[j]); s1 = g1[j] * s1 + bhi(dv[j]); } }
        } else {
            const int tt = task - 2 * T_GR; const int seq = tt / (ML_BLK / 2), w = tt % (ML_BLK / 2);
            unsigned* base = (unsigned*)(cx.ws + ST_M) + (size_t)seq * NCH * (ML_BLK / 2) + w; float* sc = (float*)(cx.ws + ST_MLSC) + (size_t)seq * NCH * 4;
            float m = 0.f, c0v = 0.f, c1v = 0.f;
            for (int c0 = 0; c0 < NCH; c0 += 8) { unsigned dv[8]; float bl[8], ml[8];
#pragma unroll
                for (int j = 0; j < 8; ++j) { dv[j] = base[(size_t)(c0 + j) * (ML_BLK / 2)]; bl[j] = sc[(c0 + j) * 4]; ml[j] = sc[(c0 + j) * 4 + 1]; }
#pragma unroll
                for (int j = 0; j < 8; ++j) { base[(size_t)(c0 + j) * (ML_BLK / 2)] = pk2(c0v, c1v); if (w == 0) sc[(c0 + j) * 4 + 2] = m;
                    const float mn = fmaxf(bl[j] + m, ml[j]), g = __expf(bl[j] + m - mn), s = __expf(ml[j] - mn);
                    c0v = g * c0v + s * blo(dv[j]); c1v = g * c1v + s * bhi(dv[j]); m = mn; } }
        }
    }
}

constexpr int ATT_LD = 264;
static_assert(256 * ATT_LD * 2 <= MISC_OFF, "attention image fits under the LDS control words");
typedef unsigned u32x2 __attribute__((ext_vector_type(2)));
typedef float f32x2_t __attribute__((ext_vector_type(2)));
typedef __bf16 bf16x2_t __attribute__((ext_vector_type(2)));
DI unsigned cvtpk(float lo, float hi) { const f32x2_t v = {lo, hi}; const bf16x2_t b = __builtin_convertvector(v, bf16x2_t); return __builtin_bit_cast(unsigned, b); }
DI void att_stage(const bf16* src, size_t src_pitch, LAS bf16* img, int tid) {
#pragma unroll 4
    for (int it = 0; it < 16; ++it) { const int c = tid + 512 * it, r = c >> 5, part = c & 31;
        const u32x4 v = *(const u32x4*)(src + (size_t)r * src_pitch + part * 8); *(LAS u32x4*)(img + r * ATT_LD + part * 8) = v; }
}
DI void attn_phase(unsigned char* ws, int l, LAS unsigned char* lds, int G, int tid, const int wave) {
    LAS bf16* img = (LAS bf16*)lds;
    const bf16* Q = (const bf16*)(ws + WS_Q); bf16* O = (bf16*)(ws + WS_O);
    const bf16* KBl = (const bf16*)(ws + WS_KB) + (size_t)l * 1024 * 1024; const bf16* VTl = (const bf16*)(ws + WS_VT) + (size_t)l * 4 * 1024 * 256;
    for (int u = blockIdx.x; u < BATCH * 4 * (SEQ / 256); u += G) {
        asm volatile("" : "+v"(tid)); const int lane = tid & 63, hf = lane >> 5, r32 = lane & 31;
        const int qt = u & 31, hd = (u >> 5) & 3, b = u >> 7;
        const size_t m0 = (size_t)b * SEQ + qt * 256 + wave * 32;
        att_stage(KBl + ((size_t)b * 256) * 1024 + hd * 256, 1024, img, tid);
        __syncthreads();
        f32x16 sa[8];
#pragma unroll
        for (int kt = 0; kt < 8; ++kt) sa[kt] = zero16();
        const bf16* qb = Q + m0 * D + hd * 256;
#pragma unroll 4
        for (int ks = 0; ks < 16; ++ks) { const bf16x8 qf = gfrag(qb, D, 0, ks * 16, lane);
#pragma unroll
            for (int kt = 0; kt < 8; ++kt) sa[kt] = mfma32(lfrag(img, ATT_LD, kt * 32, ks * 16, lane), qf, sa[kt]); }
        float mx = -3.0e38f;
#pragma unroll
        for (int kt = 0; kt < 8; ++kt)
#pragma unroll
            for (int r = 0; r < 16; ++r) mx = fmaxf(mx, sa[kt][r]);
        mx = fmaxf(mx, __shfl_xor(mx, 32));
        float sum = 0.f; unsigned pf[8][2][4];
#pragma unroll
        for (int kt = 0; kt < 8; ++kt) {
#pragma unroll
            for (int r = 0; r < 16; ++r) { sa[kt][r] = __expf(sa[kt][r] - mx); sum += sa[kt][r]; }
#pragma unroll
            for (int s = 0; s < 2; ++s)
#pragma unroll
                for (int j = 0; j < 4; ++j) pf[kt][s][j] = cvtpk(sa[kt][8 * s + 2 * j], sa[kt][8 * s + 2 * j + 1]); }
        sum += __shfl_xor(sum, 32);
        const float inv = __builtin_amdgcn_rcpf(sum);
        __syncthreads();
        att_stage(VTl + ((size_t)b * 1024 + hd * 256) * 256, 256, img, tid);
        __syncthreads();
        f32x16 oa[8];
#pragma unroll
        for (int vt = 0; vt < 8; ++vt) oa[vt] = zero16();
#pragma unroll
        for (int kt = 0; kt < 8; ++kt)
#pragma unroll
            for (int s = 0; s < 2; ++s) { u32x4 pa; pa.x = pf[kt][s][0]; pa.y = pf[kt][s][1]; pa.z = pf[kt][s][2]; pa.w = pf[kt][s][3];
                const bf16x8 a = __builtin_bit_cast(bf16x8, pa);
#pragma unroll
                for (int vt = 0; vt < 8; ++vt) { const LAS bf16* vp = img + (vt * 32 + r32) * ATT_LD + kt * 32 + 16 * s + 4 * hf;
                    const u32x2 lo = *(const LAS u32x2*)vp, hi = *(const LAS u32x2*)(vp + 8);
                    u32x4 bb; bb.x = lo.x; bb.y = lo.y; bb.z = hi.x; bb.w = hi.y;
                    oa[vt] = mfma32(a, __builtin_bit_cast(bf16x8, bb), oa[vt]); } }
        bf16* ob = O + m0 * D + hd * 256;
#pragma unroll
        for (int r = 0; r < 16; ++r) { const int i0 = crow(r, hf); const float sc = __shfl(inv, i0);
#pragma unroll
            for (int vt = 0; vt < 8; ++vt) ob[(size_t)i0 * D + vt * 32 + r32] = f2bf(oa[vt][r] * sc); }
        __syncthreads();
    }
}
DI void final_phase(const Args& args, int gw, int ngw, int lane) {
    const float* part = (const float*)(args.ws + WS_PART); const f32x4* g = (const f32x4*)argp(args, I_GFINAL); float* out = args.out; const bf16* xb = (const bf16*)(args.ws + WS_XB);
    f32x4 gg[4];
#pragma unroll
    for (int j = 0; j < 4; ++j) gg[j] = g[lane + 64 * j];
    for (int m = gw; m < M; m += ngw) { const float r = row_rstd(part, m); f32x4* orow = (f32x4*)(out + (size_t)m * D); const uint2* xr = (const uint2*)(xb + (size_t)m * D);
#pragma unroll
        for (int j = 0; j < 4; ++j) { const uint2 v = xr[lane + 64 * j]; const f32x4 x = {blo(v.x), bhi(v.x), blo(v.y), bhi(v.y)}; orow[lane + 64 * j] = x * r * gg[j]; } }
}
#ifndef PROBE
#define PROBE 0
#endif
#define IN(k) (lo <= (k) && (k) < hi)
#define SEAM(k) do { if (hi > (k) + 1) xcd_barrier(bar); } while (0)
#define WSP(T, off) ((T*)(ws + (off)))
#define PHASE_IDS() int tid = wave * 64 + lane_id(); asm volatile("" : "+v"(tid)); int lane = tid & 63
constexpr int RSTD_OFF = RING_BYTES;
static_assert(RSTD_OFF + 4096 <= MISC_OFF, "rstd table fits under the LDS control words");
DI pg8::RstdTab rstd_table(const pg8::StaticOrder& S, const float* part, LAS unsigned char* lds, int tid) {
    pg8::RstdTab rt; rt.tab = (const LAS float*)(lds + RSTD_OFF); rt.part = part; rt.g0 = 0; rt.c7 = -1;
    pg8::Unit u0;
    if (S.next(0, u0)) { rt.g0 = u0.pm >> 3; rt.c7 = u0.pm & 7;
        LAS float* tab = (LAS float*)(lds + RSTD_OFF);
        for (int e = tid; e < 1024; e += NTHR) { const int pm = 8 * (rt.g0 + (e >> 8)) + rt.c7; if (pm < S.nM) tab[e] = row_rstd(part, pm * 256 + (e & 255)); } }
    __syncthreads();
    return rt;
}
#define GEMM_SITE_RT(EpiT, gexpr, ...) do { pg8::Gemm g = gexpr; pg8::StaticOrder S; S.init(g.M, g.N, G, (int)blockIdx.x); int tid_rt = wave * 64 + lane_id(); asm volatile("" : "+v"(tid_rt)); \
        const pg8::RstdTab rt = rstd_table(S, WSP(float, WS_PART), lds, tid_rt); pg8::EpiT E = pg8::EpiT{rt, __VA_ARGS__}; pg8::gemm_phase<pg8::EpiT, pg8::StaticOrder, true, true>(lds, g, S, E, wave); } while (0)
#define GEMM_SITE(EpiT, gexpr, eexpr) do { pg8::Gemm g = gexpr; pg8::StaticOrder S; S.init(g.M, g.N, G, (int)blockIdx.x); pg8::EpiT E = eexpr; pg8::gemm_phase<pg8::EpiT, pg8::StaticOrder, true, true>(lds, g, S, E, wave); } while (0)

template <int L>
DI void layer_phases(const Args& args, LAS unsigned char* lds, const XcdBarrier& bar, const int lo, const int hi, const int G, const int wave) {
    unsigned char* const ws = args.ws;
    constexpr int l = L, base = PH_L0 + L * PH_PER_LAYER;
    const int gw = blockIdx.x * NWAVES + wave, ngw = G * NWAVES;
    if (IN(base + LP_CONV)) { if (l > 0) { PHASE_IDS(); convert_layer(args, l, (LAS float*)(lds + wave * WSLICE), gw, ngw, lane); if (PROBE & 8) { xcd_barrier(bar); convert_layer(args, l, (LAS float*)(lds + wave * WSLICE), gw, ngw, lane); } } SEAM(base + LP_CONV); }
    if (IN(base + LP_GUA)) {
        GEMM_SITE_RT(EpiSwiglu, (pg8::Gemm{WSP(bf16, WS_XB), WSP(bf16, WS_WL + WL_GUA), M, 2 * DFF, D}), WSP(bf16, WS_H));
        if (PROBE & 1) { xcd_barrier(bar);
        GEMM_SITE_RT(EpiSwiglu, (pg8::Gemm{WSP(bf16, WS_XB), WSP(bf16, WS_WL + WL_GUA), M, 2 * DFF, D}), WSP(bf16, WS_H));
        }
        SEAM(base + LP_GUA); }
    if (IN(base + LP_DNA)) {
        GEMM_SITE(EpiRes, (pg8::Gemm{WSP(bf16, WS_H), WSP(bf16, WS_WL + WL_DNA), M, D, DFF}), (pg8::EpiRes{WSP(bf16, WS_XB), WSP(float, WS_PART), 0.5f}));
        if (PROBE & 32) { xcd_barrier(bar);
        GEMM_SITE(EpiRes, (pg8::Gemm{WSP(bf16, WS_H), WSP(bf16, WS_WL + WL_DNA), M, D, DFF}), (pg8::EpiRes{WSP(bf16, WS_XB), WSP(float, WS_PART), 0.0f}));
        }
        SEAM(base + LP_DNA); }
    if (IN(base + LP_WIN)) {
        GEMM_SITE_RT(EpiScale, (pg8::Gemm{WSP(bf16, WS_XB), WSP(bf16, WS_WL + WL_IN), M, DINP, D}), WSP(bf16, WS_P), DINP, 1.f);
        if (PROBE & 1) { xcd_barrier(bar);
        GEMM_SITE_RT(EpiScale, (pg8::Gemm{WSP(bf16, WS_XB), WSP(bf16, WS_WL + WL_IN), M, DINP, D}), WSP(bf16, WS_P), DINP, 1.f);
        }
        SEAM(base + LP_WIN); }
    if (IN(base + LP_MIXA) || IN(base + LP_SCAN) || IN(base + LP_MIXB)) {
        MixCtx cx; cx.ws = ws; cx.w_a2 = (const float*)argp(args, I_GLAWA2) + (size_t)l * 16 * 192; cx.b_a = (const float*)argp(args, I_GLABA) + l * 192; cx.gla_gn = (const float*)argp(args, I_GLAGN) + l * 384;
        cx.ret_gn = (const float*)argp(args, I_RETGN) + l * 384; cx.conv = (const float*)argp(args, I_MLCONV) + (size_t)l * 4 * 512; cx.b_i = (const float*)argp(args, I_MLBI) + l * 4; cx.b_f = (const float*)argp(args, I_MLBF) + l * 4;
        if (IN(base + LP_MIXA)) { PHASE_IDS(); mix_passA(cx, lds + wave * WSLICE, gw, ngw, lane); SEAM(base + LP_MIXA); }
        if (IN(base + LP_SCAN)) { PHASE_IDS(); mix_scan(cx, blockIdx.x * NTHR + tid, G * NTHR); SEAM(base + LP_SCAN); }
        if (PROBE & 2) { { PHASE_IDS(); mix_passA(cx, lds + wave * WSLICE, gw, ngw, lane); } xcd_barrier(bar); { PHASE_IDS(); mix_scan(cx, blockIdx.x * NTHR + tid, G * NTHR); } xcd_barrier(bar); { PHASE_IDS(); mix_passB(cx, lds + wave * WSLICE, gw, ngw, lane); } xcd_barrier(bar); }
        if (IN(base + LP_MIXB)) { { PHASE_IDS(); mix_passB(cx, lds + wave * WSLICE, gw, ngw, lane); } if (PROBE & 16) { xcd_barrier(bar); PHASE_IDS(); mix_passB(cx, lds + wave * WSLICE, gw, ngw, lane); } SEAM(base + LP_MIXB); }
    }
    if (IN(base + LP_WOUT)) {
        GEMM_SITE(EpiRes, (pg8::Gemm{WSP(bf16, WS_Y), WSP(bf16, WS_WL + WL_OUT), M, D, D}), (pg8::EpiRes{WSP(bf16, WS_XB), WSP(float, WS_PART), 1.0f}));
        if (PROBE & 32) { xcd_barrier(bar);
        GEMM_SITE(EpiRes, (pg8::Gemm{WSP(bf16, WS_Y), WSP(bf16, WS_WL + WL_OUT), M, D, D}), (pg8::EpiRes{WSP(bf16, WS_XB), WSP(float, WS_PART), 0.0f}));
        }
        SEAM(base + LP_WOUT); }
    if (IN(base + LP_XQ)) {
        GEMM_SITE_RT(EpiScale, (pg8::Gemm{WSP(bf16, WS_XB), WSP(bf16, WS_WL + WL_XQ), M, D, D}), WSP(bf16, WS_Q), D, 0.0625f);
        if (PROBE & 1) { xcd_barrier(bar);
        GEMM_SITE_RT(EpiScale, (pg8::Gemm{WSP(bf16, WS_XB), WSP(bf16, WS_WL + WL_XQ), M, D, D}), WSP(bf16, WS_Q), D, 0.0625f);
        }
        SEAM(base + LP_XQ); }
    if (IN(base + LP_ATT)) { PHASE_IDS(); (void)lane; attn_phase(ws, l, lds, G, tid, wave); if (PROBE & 4) { xcd_barrier(bar); attn_phase(ws, l, lds, G, tid, wave); } SEAM(base + LP_ATT); }
    if (IN(base + LP_XO)) {
        GEMM_SITE(EpiRes, (pg8::Gemm{WSP(bf16, WS_O), WSP(bf16, WS_WL + WL_XO), M, D, D}), (pg8::EpiRes{WSP(bf16, WS_XB), WSP(float, WS_PART), 1.0f}));
        if (PROBE & 32) { xcd_barrier(bar);
        GEMM_SITE(EpiRes, (pg8::Gemm{WSP(bf16, WS_O), WSP(bf16, WS_WL + WL_XO), M, D, D}), (pg8::EpiRes{WSP(bf16, WS_XB), WSP(float, WS_PART), 0.0f}));
        }
        SEAM(base + LP_XO); }
    if (IN(base + LP_GUB)) {
        GEMM_SITE_RT(EpiSwiglu, (pg8::Gemm{WSP(bf16, WS_XB), WSP(bf16, WS_WL + WL_GUB), M, 2 * DFF, D}), WSP(bf16, WS_H));
        if (PROBE & 1) { xcd_barrier(bar);
        GEMM_SITE_RT(EpiSwiglu, (pg8::Gemm{WSP(bf16, WS_XB), WSP(bf16, WS_WL + WL_GUB), M, 2 * DFF, D}), WSP(bf16, WS_H));
        }
        SEAM(base + LP_GUB); }
    if (IN(base + LP_DNB)) {
        GEMM_SITE(EpiRes, (pg8::Gemm{WSP(bf16, WS_H), WSP(bf16, WS_WL + WL_DNB), M, D, DFF}), (pg8::EpiRes{WSP(bf16, WS_XB), WSP(float, WS_PART), 0.5f}));
        if (PROBE & 32) { xcd_barrier(bar);
        GEMM_SITE(EpiRes, (pg8::Gemm{WSP(bf16, WS_H), WSP(bf16, WS_WL + WL_DNB), M, D, DFF}), (pg8::EpiRes{WSP(bf16, WS_XB), WSP(float, WS_PART), 0.0f}));
        }
        SEAM(base + LP_DNB); }
}

__global__ void __launch_bounds__(NTHR, 2) fwd(Args args) {
    extern __shared__ __attribute__((aligned(16))) unsigned char lds_raw[];
    LAS unsigned char* lds = (LAS unsigned char*)lds_raw;
    const int wave = __builtin_amdgcn_readfirstlane((int)threadIdx.x >> 6);
    const int G = gridDim.x;
    unsigned char* const ws = args.ws;
    for (int u = wave * 64 + lane_id(); u < (LDS_BYTES - MISC_OFF) / 4; u += NTHR) ((LAS unsigned*)(lds + MISC_OFF))[u] = 0u;
    __syncthreads();
    const XcdBarrier bar = xcd_barrier_post((unsigned*)(ws + WS_CTL) + CW_BAR + args.li * XCD_BAR_WORDS, (volatile LAS unsigned*)(lds + MISC_OFF), wave);
    const int lo = args.ph_lo, hi = args.ph_hi;

    if (IN(PH_PRO)) { PHASE_IDS();
        const int gw = blockIdx.x * NWAVES + wave, ngw = G * NWAVES; LAS float* scr = (LAS float*)(lds + wave * WSLICE);
        convert_kv(args, scr, gw, ngw, lane);
        convert_layer(args, 0, scr, gw, ngw, lane);
        { const float* x = (const float*)argp(args, I_X); for (int m = gw; m < M; m += ngw) stats_row(x + (size_t)m * D, WSP(bf16, WS_XB) + (size_t)m * D, WSP(float, WS_PART) + (size_t)m * 16, lane); }
        { const float* mem = (const float*)argp(args, I_MEM); for (int m = gw; m < BATCH * MEMLEN; m += ngw) stats_row(mem + (size_t)m * D, WSP(bf16, WS_MEMB) + (size_t)m * D, WSP(float, WS_MEMP) + (size_t)m * 16, lane); }
        { const int* pos = (const int*)argp(args, I_POS); float2* rope = WSP(float2, WS_ROPE);
          for (int i = blockIdx.x * NTHR + tid; i < M * 16; i += G * NTHR) { const int r = i >> 4, m = i & 15;
            const float invf = 1.0f / powf(10000.0f, (float)m / 15.0f); const float ang = (float)pos[r] * invf;
            rope[i] = make_float2((float)cos((double)ang), (float)sin((double)ang)); } }
        SEAM(PH_PRO);
    }
    if (IN(PH_KV)) {
        GEMM_SITE(EpiKV, (pg8::Gemm{WSP(bf16, WS_MEMB), WSP(bf16, WS_WKV), BATCH * MEMLEN, DEPTH * 2048, D}), (pg8::EpiKV{WSP(float, WS_MEMP), WSP(bf16, WS_KB), WSP(bf16, WS_VT)}));
        SEAM(PH_KV);
    }
    layer_phases<0>(args, lds, bar, lo, hi, G, wave);
    layer_phases<1>(args, lds, bar, lo, hi, G, wave);
    layer_phases<2>(args, lds, bar, lo, hi, G, wave);
    layer_phases<3>(args, lds, bar, lo, hi, G, wave);
    if (IN(PH_FINAL)) { PHASE_IDS(); final_phase(args, blockIdx.x * NWAVES + wave, G * NWAVES, lane); }
}
#undef IN
#undef SEAM
extern "C" void kernel_launch(void* const* d_in, const int* in_sizes, int n_in, void* d_out, int out_size, void* d_ws, size_t ws_size, hipStream_t stream) {
    static int grid = 0;
    if (grid == 0) {
        if (n_in != 25 || ws_size < WS_END || out_size != M * D) { fprintf(stderr, "kernel_launch: unexpected inputs (n_in %d, ws %zu, out %d)\n", n_in, ws_size, out_size); grid = -1; return; }
        int dev = 0, cus = 0, per_cu = 0;
        if (hipGetDevice(&dev) != hipSuccess || hipDeviceGetAttribute(&cus, hipDeviceAttributeMultiprocessorCount, dev) != hipSuccess) { grid = -1; return; }
        if (hipFuncSetAttribute((const void*)fwd, hipFuncAttributeMaxDynamicSharedMemorySize, LDS_BYTES) != hipSuccess) { fprintf(stderr, "kernel_launch: hipFuncSetAttribute failed\n"); grid = -1; return; }
        if (hipOccupancyMaxActiveBlocksPerMultiprocessor(&per_cu, (const void*)fwd, NTHR, LDS_BYTES) != hipSuccess || per_cu < 1) fprintf(stderr, "kernel_launch: occupancy query says %d\n", per_cu);
        (void)hipGetLastError();
        grid = cus;
    }
    if (grid < 0) return;
    hipMemsetAsync((char*)d_ws + WS_CTL, 0, 1 * MiB, stream);
    unsigned char* ws = (unsigned char*)d_ws; float* out = (float*)d_out;
    int li = 0;
    auto launch = [&](int lo, int hi) {
        Args a{}; for (int i = 0; i < 25; ++i) a.in[i] = d_in[i];
        a.out = out; a.ws = ws; a.ph_lo = lo; a.ph_hi = hi; a.li = li++; a.pad = 0;
        hipLaunchKernelGGL(fwd, dim3(grid), dim3(NTHR), LDS_BYTES, stream, a);
    };
    launch(PH_PRO, PH_END);
}
```

```cpp
#define EPIPROBE 0
#define CLKPROBE 0
#define WAITPROBE 0
#define WAITSEL 0x7fff
#define REPPROBE 0
#include <hip/hip_runtime.h>
#include <cstdio>
#include <cstdint>

typedef unsigned short bf16;
typedef short bf16x8 __attribute__((ext_vector_type(8)));
typedef float f32x4 __attribute__((ext_vector_type(4)));
typedef float f32x16 __attribute__((ext_vector_type(16)));
typedef unsigned u32x4 __attribute__((ext_vector_type(4)));
#define DI __device__ __forceinline__
#define LAS __attribute__((address_space(3)))

constexpr int BATCH = 4, SEQ = 8192, D = 1024, DEPTH = 4, MEMLEN = 256;
constexpr int M = BATCH * SEQ;
constexpr int DFF = 2816, DIN = 3352, DINP = 3584;
constexpr float EPS = 1e-6f;
constexpr int C_GQ = 0, C_GK = 192, C_GV = 384, C_GA = 768, C_GR = 784, C_RQ = 1168, C_RK = 1360, C_RV = 1552, C_RG = 1936,
              C_MQ = 2320, C_MK = 2576, C_MV = 2832, C_MO = 3088, C_MI = 3344, C_MF = 3348;

constexpr size_t MiB = 1u << 20;
constexpr size_t WS_CTL = 0, WS_ROPE = 1 * MiB, WS_PART = 5 * MiB, WS_MEMB = 7 * MiB, WS_MEMP = 9 * MiB, WS_KB = 10 * MiB, WS_VT = 18 * MiB,
                 WS_WKV = 26 * MiB, WS_WL = 42 * MiB, WS_XB = 88 * MiB, WS_R = 152 * MiB,
                 WS_P = WS_R, WS_ST = 376 * MiB, WS_H = WS_R, WS_Q = 328 * MiB, WS_O = 392 * MiB, WS_Y = 456 * MiB, WS_END = 520 * MiB;
constexpr size_t WL_GUA = 0, WL_DNA = WL_GUA + (size_t)2 * DFF * D * 2, WL_IN = WL_DNA + (size_t)D * DFF * 2, WL_OUT = WL_IN + (size_t)DINP * D * 2,
                 WL_XQ = WL_OUT + (size_t)D * D * 2, WL_XO = WL_XQ + (size_t)D * D * 2, WL_GUB = WL_XO + (size_t)D * D * 2, WL_DNB = WL_GUB + (size_t)2 * DFF * D * 2,
                 WL_END = WL_DNB + (size_t)D * DFF * 2;
static_assert(WS_WL + WL_END <= WS_XB, "per-layer weights fit");
static_assert(WS_P + (size_t)M * DINP * 2 <= WS_ST && WS_H + (size_t)M * DFF * 2 <= WS_Q && WS_Q + (size_t)M * D * 2 <= WS_O && WS_O + (size_t)M * D * 2 <= WS_Y && WS_Y + (size_t)M * D * 2 <= WS_END && WS_ST + 44 * MiB <= WS_Y, "ws map");
constexpr int CW_BAR = 0;
constexpr size_t CTL_ZERO_BYTES = 36864;

DI float bf2f(bf16 b) { return __uint_as_float(((unsigned)b) << 16); }
typedef float f32x2_t_ __attribute__((ext_vector_type(2)));
typedef __bf16 bf16x2_t_ __attribute__((ext_vector_type(2)));
DI unsigned pk2(float lo, float hi) { const f32x2_t_ v = {lo, hi}; const bf16x2_t_ b = __builtin_convertvector(v, bf16x2_t_); return __builtin_bit_cast(unsigned, b); }
DI bf16 f2bf(float f) { return (bf16)(pk2(f, f) & 0xffffu); }
DI float sigmoidf_(float x) { return __builtin_amdgcn_rcpf(1.f + __expf(-x)); }
DI float siluf_(float x) { return x * __builtin_amdgcn_rcpf(1.f + __expf(-x)); }
DI float logsigf_(float x) { return fminf(x, 0.f) - __logf(1.f + __expf(-fabsf(x))); }
DI float wave_sum(float v) {
#pragma unroll
    for (int o = 1; o < 64; o <<= 1) v += __shfl_xor(v, o);
    return v;
}
DI float wave_max(float v) {
#pragma unroll
    for (int o = 1; o < 64; o <<= 1) v = fmaxf(v, __shfl_xor(v, o));
    return v;
}
DI float row_rstd(const float* part, int row) {
    const f32x4* p = (const f32x4*)(part + (size_t)row * 16);
    const f32x4 a = p[0], b = p[1], c = p[2], d = p[3];
    const float s = ((a.x + a.y) + (a.z + a.w)) + ((b.x + b.y) + (b.z + b.w)) + ((c.x + c.y) + (c.z + c.w)) + ((d.x + d.y) + (d.z + d.w));
    return rsqrtf(s * (1.f / D) + EPS);
}
DI int lane_id() { int l; asm volatile("v_mbcnt_lo_u32_b32 %0, -1, 0\n\tv_mbcnt_hi_u32_b32 %0, -1, %0" : "=v"(l)); return l; }
namespace pg8 {
#define PG8_LAS __attribute__((address_space(3)))
typedef unsigned short bf16_t;
typedef short bf16x8 __attribute__((ext_vector_type(8)));
typedef float f32x4 __attribute__((ext_vector_type(4)));
typedef unsigned u32x4 __attribute__((ext_vector_type(4)));
constexpr int BM = 256, BK = 64, HALF = 128, HTB = HALF * BK * 2  , STAGE_BYTES = 8 * HTB, NXCD = 8, WGM = 8;

__host__ __device__ __forceinline__ int lds_byte(int r, int c) { const int st = (r >> 4) * 2 + (c >> 5), rr = r & 15, cc = c & 31, ob = rr * 64 + cc * 2; return st * 1024 + (ob ^ (((ob >> 9) & 1) << 5)); }
__host__ __device__ __forceinline__ void stage_rc(int b, int& R, int& C) { const int st = b / 1024, sb = b % 1024, swz = sb ^ (((sb >> 9) & 1) << 5); R = (st >> 1) * 16 + swz / 64; C = (st & 1) * 32 + (swz % 64) / 2; }
__host__ __device__ __forceinline__ int perm32(int rho) { const int n = rho >> 4, i = rho & 15; return 8 * (i >> 2) + 4 * n + (i & 3); }

struct Unit { int pm, pn, idx; };
struct Gemm { const bf16_t* A; const bf16_t* Bt; int M, N, K; };

struct StaticOrder {
    int nM, nN, nwg, G, c;
    __host__ __device__ void init(int M, int N, int G_, int c_) { nM = M / BM; nN = N / BM; nwg = nM * nN; G = G_; c = c_; }
    __host__ __device__ bool next(int i, Unit& u) const {
        const long L = (long)i * G + c; if (L >= nwg) return false;
        int wgid = (int)L; { const int q = nwg / NXCD, r = nwg % NXCD, xcd = wgid % NXCD, off = wgid / NXCD; wgid = (xcd < r ? xcd * (q + 1) : r * (q + 1) + (xcd - r) * q) + off; }
        const int nig = WGM * nN, gid = wgid / nig, fm = gid * WGM, gsz = (nM - fm) < WGM ? (nM - fm) : WGM;
        u.pm = fm + ((wgid % nig) % gsz); u.pn = (wgid % nig) / gsz; u.idx = i; return true;
    }
    __device__ __forceinline__ void a_ready(const Unit&) const {}
    __device__ __forceinline__ void done(const Unit&) const {}
};

__device__ __forceinline__ unsigned cvt_pk_bf16(float lo, float hi) { unsigned r; asm volatile("v_cvt_pk_bf16_f32 %0, %1, %2" : "=v"(r) : "v"(lo), "v"(hi)); return r; }
__device__ __forceinline__ u32x4 pack8(const f32x4 v0, const f32x4 v1) { u32x4 w; w.x = cvt_pk_bf16(v0[0], v0[1]); w.y = cvt_pk_bf16(v0[2], v0[3]); w.z = cvt_pk_bf16(v1[0], v1[1]); w.w = cvt_pk_bf16(v1[2], v1[3]); return w; }
__device__ __forceinline__ f32x4 silu4(const f32x4 a) { f32x4 r; r[0] = siluf_(a[0]); r[1] = siluf_(a[1]); r[2] = siluf_(a[2]); r[3] = siluf_(a[3]); return r; }

struct RstdTab { const PG8_LAS float* tab;
    __device__ __forceinline__ float get(const Unit& u, int r) const { return tab[u.idx * 256 + r]; } };
struct EpiSwiglu {
    static constexpr bool PERM = true, AFTER_DRAIN = false, IDEMP = true;
    RstdTab rt; bf16_t* H;
    __device__ __forceinline__ static f32x4 swiglu4(const f32x4 a, const f32x4 g, float c1, float rs2) {
        const f32x4 t = a * c1; f32x4 e; e[0] = __builtin_amdgcn_exp2f(t[0]); e[1] = __builtin_amdgcn_exp2f(t[1]); e[2] = __builtin_amdgcn_exp2f(t[2]); e[3] = __builtin_amdgcn_exp2f(t[3]);
        const f32x4 d = e + 1.0f; f32x4 r; r[0] = __builtin_amdgcn_rcpf(d[0]); r[1] = __builtin_amdgcn_rcpf(d[1]); r[2] = __builtin_amdgcn_rcpf(d[2]); r[3] = __builtin_amdgcn_rcpf(d[3]);
        return ((a * g) * rs2) * r; }
    __device__ __forceinline__ void operator()(const f32x4 (&acc)[2][2][4][2], const Unit& u, int wr, int wc, int fr, int fq) const {
        const int r0 = wr * 64 + fr, col0 = u.pn * 128 + wc * 32 + 8 * fq;
#pragma unroll
        for (int ai = 0; ai < 2; ++ai)
#pragma unroll
            for (int m = 0; m < 4; ++m) { const int r = r0 + ai * HALF + m * 16; const float rs = rt.get(u, r), c1 = rs * -1.4426950408889634f, rs2 = rs * rs;
                *(u32x4*)(H + (size_t)(u.pm * BM + r) * DFF + col0) = pack8(swiglu4(acc[ai][0][m][0], acc[ai][1][m][0], c1, rs2), swiglu4(acc[ai][0][m][1], acc[ai][1][m][1], c1, rs2)); }
    }
};
struct EpiRes {
    static constexpr bool PERM = true, AFTER_DRAIN = false, IDEMP = false;
    bf16_t* xb; float* part; float alpha;
    __device__ __forceinline__ void operator()(const f32x4 (&acc)[2][2][4][2], const Unit& u, int wr, int wc, int fr, int fq) const {
        const int row0 = u.pm * BM + wr * 64 + fr, col0 = u.pn * BM + wc * 32 + 8 * fq;
        u32x4 xv[2][4][2];
#pragma unroll
        for (int ai = 0; ai < 2; ++ai)
#pragma unroll
            for (int m = 0; m < 4; ++m)
#pragma unroll
                for (int bj = 0; bj < 2; ++bj) xv[ai][m][bj] = *(const u32x4*)(xb + (size_t)(row0 + ai * HALF + m * 16) * D + col0 + bj * HALF);
#pragma unroll
        for (int ai = 0; ai < 2; ++ai)
#pragma unroll
            for (int m = 0; m < 4; ++m) { const int row = row0 + ai * HALF + m * 16; bf16_t* xp = xb + (size_t)row * D + col0; float ss = 0.f;
#pragma unroll
                for (int bj = 0; bj < 2; ++bj) { const u32x4 v = xv[ai][m][bj];
                    const f32x4 x0 = {__uint_as_float(v.x << 16), __uint_as_float(v.x & 0xffff0000u), __uint_as_float(v.y << 16), __uint_as_float(v.y & 0xffff0000u)};
                    const f32x4 x1 = {__uint_as_float(v.z << 16), __uint_as_float(v.z & 0xffff0000u), __uint_as_float(v.w << 16), __uint_as_float(v.w & 0xffff0000u)};
                    const f32x4 y0 = x0 + acc[ai][bj][m][0] * alpha, y1 = x1 + acc[ai][bj][m][1] * alpha;
                    *(u32x4*)(xp + bj * HALF) = pack8(y0, y1);
                    ss += ((y0[0] * y0[0] + y0[1] * y0[1]) + (y0[2] * y0[2] + y0[3] * y0[3])) + ((y1[0] * y1[0] + y1[1] * y1[1]) + (y1[2] * y1[2] + y1[3] * y1[3])); }
                ss += __shfl_xor(ss, 16); ss += __shfl_xor(ss, 32);
                if (fq == 0) part[(size_t)row * 16 + u.pn * 4 + wc] = ss; }
    }
};
struct EpiScale {
    static constexpr bool PERM = true, AFTER_DRAIN = false, IDEMP = true;
    RstdTab rt; bf16_t* O; int ldc; float scale;
    __device__ __forceinline__ void operator()(const f32x4 (&acc)[2][2][4][2], const Unit& u, int wr, int wc, int fr, int fq) const {
        const int r0 = wr * 64 + fr, col0 = u.pn * BM + wc * 32 + 8 * fq;
#pragma unroll
        for (int ai = 0; ai < 2; ++ai)
#pragma unroll
            for (int m = 0; m < 4; ++m) { const int r = r0 + ai * HALF + m * 16; const float rs = rt.get(u, r) * scale; const int row = u.pm * BM + r;
                bf16_t* rowp = ldc ? O + (size_t)row * ldc + col0 : O + (((size_t)(row >> 6) * (DINP / 16) + (col0 >> 4)) * 64 + (row & 63)) * 16 + (col0 & 15);
#pragma unroll
                for (int bj = 0; bj < 2; ++bj) *(u32x4*)(rowp + (ldc ? bj * HALF : bj * (HALF / 16) * 1024)) = pack8(acc[ai][bj][m][0] * rs, acc[ai][bj][m][1] * rs); }
    }
};
struct EpiKV {
    static constexpr bool PERM = true, AFTER_DRAIN = false, IDEMP = false;
    const float* mp; bf16_t* KB; bf16_t* VT;
    __device__ __forceinline__ void operator()(const f32x4 (&acc)[2][2][4][2], const Unit& u, int wr, int wc, int fr, int fq) const {
        const int l = u.pn >> 3, pc = u.pn & 7; const int row0 = u.pm * BM + wr * 64 + fr;
#pragma unroll
        for (int ai = 0; ai < 2; ++ai)
#pragma unroll
            for (int m = 0; m < 4; ++m) { const int row = row0 + ai * HALF + m * 16; const float rs = rsqrtf(mp[(size_t)row * 16] * (1.f / D) + EPS);
#pragma unroll
                for (int bj = 0; bj < 2; ++bj) { const f32x4 v0 = acc[ai][bj][m][0] * rs, v1 = acc[ai][bj][m][1] * rs;
                    if (pc < 4) { *(u32x4*)(KB + ((size_t)l * 1024 + row) * 1024 + pc * 256 + bj * HALF + wc * 32 + 8 * fq) = pack8(v0, v1); }
                    else { const int vc = (pc - 4) * 256 + bj * HALF + wc * 32 + 8 * fq; const int key = row & 255, kp = (key & ~12) | ((key & 4) << 1) | ((key & 8) >> 1);
                        bf16_t* vp = VT + (((size_t)l * 4 + u.pm) * 1024 + vc) * 256 + kp;
#pragma unroll
                        for (int e = 0; e < 4; ++e) { vp[(size_t)e * 256] = f2bf(v0[e]); vp[(size_t)(e + 4) * 256] = f2bf(v1[e]); } } } }
    }
};
template <class Epi, class Sched, bool ALIGN_EPI = false, bool SP2 = false>
__device__ __forceinline__ void gemm_phase(PG8_LAS unsigned char* lds, const Gemm g, const Sched& S, const Epi& E, const int wave_) {
    int tid_ = wave_ * 64 + lane_id(); asm volatile("" : "+v"(tid_));
    const int tid = tid_, wid = wave_, lane = tid & 63, wr = wid >> 2, wc = wid & 3, fr = lane & 15, fq = lane >> 4;
    const int K = g.K, nt = K / BK;
    unsigned voffA[2], voffB[2];
#pragma unroll
    for (int i = 0; i < 2; ++i) { int R, C; stage_rc(tid * 16 + i * 8192, R, C); const int Rb = Epi::PERM ? ((R & ~31) + perm32(R & 31)) : R;
        voffA[i] = (unsigned)(R * K + C) * 2u; voffB[i] = (unsigned)(Rb * K + C) * 2u; }
    const size_t kstep = (size_t)(BK * 2);
    const size_t hstep = (size_t)HALF * K * 2;
    const size_t tstep = 2 * hstep;
    const unsigned ldsw = (unsigned)wid * 1024u;
    const int aoff = lds_byte(wr * 64 + fr, fq * 8), boff = lds_byte(wc * 32 + fr, fq * 8);
#define PG8_SA(b, h) (((b) * 2 + (h)) * HTB)
#define PG8_SB(b, h) ((4 + (b) * 2 + (h)) * HTB)
#define PG8_STAGE(bufoff, gbase, voff) do { _Pragma("unroll") for (int _i = 0; _i < 2; ++_i) \
        __builtin_amdgcn_global_load_lds((const unsigned*)((const char*)(gbase) + (voff)[_i]), (PG8_LAS unsigned*)(lds + (bufoff) + ldsw + _i * 8192), 16, 0, 0); } while (0)
#define PG8_LDA(dst, b, h) do { _Pragma("unroll") for (int m = 0; m < 4; ++m) _Pragma("unroll") for (int k = 0; k < 2; ++k) dst[m][k] = *(const PG8_LAS bf16x8*)(lds + PG8_SA(b, h) + aoff + m * 2048 + k * 1024); } while (0)
#define PG8_LDB(dst, b, h) do { _Pragma("unroll") for (int n = 0; n < 2; ++n) _Pragma("unroll") for (int k = 0; k < 2; ++k) dst[n][k] = *(const PG8_LAS bf16x8*)(lds + PG8_SB(b, h) + boff + n * 2048 + k * 1024); } while (0)
#define PG8_MMA(ai, bj, At, Bt) do { __builtin_amdgcn_s_setprio(1); _Pragma("unroll") for (int m = 0; m < 4; ++m) _Pragma("unroll") for (int n = 0; n < 2; ++n) _Pragma("unroll") for (int k = 0; k < 2; ++k) \
        acc[ai][bj][m][n] = __builtin_amdgcn_mfma_f32_16x16x32_bf16(Bt[n][k], At[m][k], acc[ai][bj][m][n], 0, 0, 0); __builtin_amdgcn_s_setprio(0); } while (0)
#define PG8_WAIT_V(n) asm volatile("s_waitcnt vmcnt(" #n ")" ::: "memory")
#define PG8_WAIT_L(n) asm volatile("s_waitcnt lgkmcnt(" #n ")" ::: "memory")
#define PG8_BAR __builtin_amdgcn_s_barrier()
#define PG8_SCHED __builtin_amdgcn_sched_barrier(0)
    Unit cur, nxt; int ui = 0;
    if (!S.next(0, cur)) return;
    f32x4 acc[2][2][4][2];
#pragma unroll
    for (int a = 0; a < 2; ++a)
#pragma unroll
        for (int b = 0; b < 2; ++b)
#pragma unroll
            for (int m = 0; m < 4; ++m)
#pragma unroll
                for (int n = 0; n < 2; ++n) acc[a][b][m][n] = (f32x4){0.f, 0.f, 0.f, 0.f};
    bf16x8 At[4][2], B0[2][2], B1[2][2];
    const char* cA = (const char*)g.A + (size_t)cur.pm * tstep; const char* cB = (const char*)g.Bt + (size_t)cur.pn * tstep;
    S.a_ready(cur);
    if constexpr (SP2) {
        PG8_STAGE(PG8_SB(0, 0), cB, voffB); PG8_STAGE(PG8_SB(0, 1), cB + hstep, voffB); PG8_STAGE(PG8_SA(0, 0), cA, voffA); PG8_STAGE(PG8_SA(0, 1), cA + hstep, voffA);
        if (wr == 1) PG8_BAR;
        PG8_WAIT_V(2); PG8_BAR;
        PG8_STAGE(PG8_SB(1, 0), cB + kstep, voffB); PG8_STAGE(PG8_SA(1, 0), cA + kstep, voffA); PG8_STAGE(PG8_SB(1, 1), cB + hstep + kstep, voffB);
        PG8_WAIT_V(6); PG8_BAR;
    } else {
        PG8_STAGE(PG8_SB(0, 0), cB, voffB); PG8_STAGE(PG8_SA(0, 0), cA, voffA); PG8_STAGE(PG8_SB(0, 1), cB + hstep, voffB); PG8_STAGE(PG8_SA(0, 1), cA + hstep, voffA);
        if (wr == 1) PG8_BAR;
        PG8_WAIT_V(4); PG8_BAR;
        PG8_STAGE(PG8_SB(1, 0), cB + kstep, voffB); PG8_STAGE(PG8_SA(1, 0), cA + kstep, voffA); PG8_STAGE(PG8_SB(1, 1), cB + hstep + kstep, voffB);
        PG8_WAIT_V(6); PG8_BAR;
    }
    for (;;) {
        const bool has_next = S.next(ui + 1, nxt);
        const char* nA = has_next ? (const char*)g.A + (size_t)nxt.pm * tstep : cA; const char* nB = has_next ? (const char*)g.Bt + (size_t)nxt.pn * tstep : cB;
        for (int t = 0; t < nt; t += 2) {
            const bool last = (t == nt - 2);
            const char* a1 = cA + (size_t)(t + 1) * kstep;
            const char* a2 = last ? nA : cA + (size_t)(t + 2) * kstep; const char* b2 = last ? nB : cB + (size_t)(t + 2) * kstep;
            const char* a3 = a2 + kstep; const char* b3 = b2 + kstep;
            if (last && has_next) S.a_ready(nxt);
            if constexpr (SP2) {
            PG8_LDB(B0, 0, 0); PG8_LDB(B1, 0, 1); PG8_SCHED; PG8_LDA(At, 0, 0); PG8_STAGE(PG8_SA(1, 1), a1 + hstep, voffA);
            PG8_WAIT_V(8); PG8_WAIT_L(0); PG8_BAR; PG8_MMA(0, 0, At, B0); PG8_MMA(0, 1, At, B1); PG8_BAR; PG8_SCHED;
            PG8_LDA(At, 0, 1); PG8_STAGE(PG8_SB(0, 0), b2, voffB); PG8_STAGE(PG8_SB(0, 1), b2 + hstep, voffB); PG8_STAGE(PG8_SA(0, 0), a2, voffA);
            PG8_WAIT_V(8); PG8_WAIT_L(0); PG8_BAR; PG8_MMA(1, 0, At, B0); PG8_MMA(1, 1, At, B1); PG8_BAR; PG8_SCHED;
            PG8_LDB(B0, 1, 0); PG8_LDB(B1, 1, 1); PG8_SCHED; PG8_LDA(At, 1, 0); PG8_STAGE(PG8_SA(0, 1), a2 + hstep, voffA);
            PG8_WAIT_V(8); PG8_WAIT_L(0); PG8_BAR; PG8_MMA(0, 0, At, B0); PG8_MMA(0, 1, At, B1); PG8_BAR; PG8_SCHED;
            PG8_LDA(At, 1, 1); PG8_STAGE(PG8_SB(1, 0), b3, voffB); PG8_STAGE(PG8_SB(1, 1), b3 + hstep, voffB); PG8_STAGE(PG8_SA(1, 0), a3, voffA);
            PG8_WAIT_V(8); PG8_WAIT_L(0); PG8_BAR; PG8_MMA(1, 0, At, B0); PG8_MMA(1, 1, At, B1); PG8_BAR; PG8_SCHED;
            } else {
            PG8_LDB(B0, 0, 0); PG8_SCHED; PG8_LDA(At, 0, 0); PG8_STAGE(PG8_SA(1, 1), a1 + hstep, voffA);
            PG8_WAIT_L(8); PG8_BAR; PG8_WAIT_L(0); PG8_MMA(0, 0, At, B0); PG8_BAR; PG8_SCHED;
            PG8_LDB(B1, 0, 1); PG8_STAGE(PG8_SB(0, 0), b2, voffB);
            PG8_BAR; PG8_WAIT_L(0); PG8_MMA(0, 1, At, B1); PG8_BAR;
            PG8_LDA(At, 0, 1); PG8_STAGE(PG8_SA(0, 0), a2, voffA);
            PG8_BAR; PG8_WAIT_L(0); PG8_MMA(1, 0, At, B0); PG8_BAR; PG8_SCHED;
            PG8_STAGE(PG8_SB(0, 1), b2 + hstep, voffB);
            PG8_WAIT_V(6); PG8_BAR; PG8_MMA(1, 1, At, B1); PG8_BAR;
            PG8_LDB(B0, 1, 0); PG8_SCHED; PG8_LDA(At, 1, 0); PG8_STAGE(PG8_SA(0, 1), a2 + hstep, voffA);
            PG8_WAIT_L(8); PG8_BAR; PG8_WAIT_L(0); PG8_MMA(0, 0, At, B0); PG8_BAR; PG8_SCHED;
            PG8_LDB(B1, 1, 1); PG8_STAGE(PG8_SB(1, 0), b3, voffB);
            PG8_BAR; PG8_WAIT_L(0); PG8_MMA(0, 1, At, B1); PG8_BAR;
            PG8_LDA(At, 1, 1); PG8_STAGE(PG8_SA(1, 0), a3, voffA);
            PG8_BAR; PG8_WAIT_L(0); PG8_MMA(1, 0, At, B0); PG8_BAR; PG8_SCHED;
            PG8_STAGE(PG8_SB(1, 1), b3 + hstep, voffB);
            PG8_WAIT_V(6); PG8_BAR; PG8_MMA(1, 1, At, B1); PG8_BAR;
            }
        }
        if constexpr (ALIGN_EPI) { if (wr == 0) PG8_BAR; }
        if constexpr (!Epi::AFTER_DRAIN) { E(acc, cur, wr, wc, fr, fq);
#if defined(EPIPROBE) && EPIPROBE
            if constexpr (Epi::IDEMP) { asm volatile("" ::: "memory"); E(acc, cur, wr, wc, fr, fq); }
#endif
            S.done(cur); }
        if (!has_next) break;
#pragma unroll
        for (int a = 0; a < 2; ++a)
#pragma unroll
            for (int b = 0; b < 2; ++b)
#pragma unroll
                for (int m = 0; m < 4; ++m)
#pragma unroll
                    for (int n = 0; n < 2; ++n) acc[a][b][m][n] = (f32x4){0.f, 0.f, 0.f, 0.f};
        cur = nxt; cA = nA; cB = nB; ++ui;
        if constexpr (ALIGN_EPI) { if (wr == 1) PG8_BAR; }
    }
    PG8_WAIT_V(0);
    if constexpr (!ALIGN_EPI) { if (wr == 0) PG8_BAR; }
    PG8_BAR;
    if constexpr (Epi::AFTER_DRAIN) { E.fused(acc, cur, wr, wc, fr, fq, lds, wid, lane); S.done(cur); }
#undef PG8_SA
#undef PG8_SB
#undef PG8_STAGE
#undef PG8_LDA
#undef PG8_LDB
#undef PG8_MMA
#undef PG8_WAIT_V
#undef PG8_WAIT_L
#undef PG8_BAR
#undef PG8_SCHED
}
}
#define XB_TMO      128
#define XB_XCNT(j)  (256  + 64 * (j))
#define XB_XSUB(j)  (1280 + 64 * (j))
#define XB_XGEN(j)  (2304 + 64 * (j))
#define XB_TOP      3328
#define XB_TOPGEN   3392
#define XCD_BAR_WORDS 3456
#define XB_SPIN_CAP (1u << 18)

__device__ __forceinline__ unsigned xb_ld(unsigned* p)              { return __hip_atomic_load(p, __ATOMIC_RELAXED, __HIP_MEMORY_SCOPE_AGENT); }
__device__ __forceinline__ unsigned xb_add(unsigned* p, unsigned v) { return __hip_atomic_fetch_add(p, v, __ATOMIC_RELAXED, __HIP_MEMORY_SCOPE_AGENT); }
__device__ __forceinline__ unsigned xb_xcc_id() { return (unsigned)__builtin_amdgcn_s_getreg((3 << 11) | 20) & 0xFu; }
#define XB_SPIN(cond, bar) do { unsigned _sp = 0; while (cond) { __builtin_amdgcn_s_sleep(1); \
    if ((++_sp & 255u) == 0u) { if (xb_ld(&(bar)[XB_TMO])) break; if (_sp > XB_SPIN_CAP) { atomicAdd(&(bar)[XB_TMO], 1u); break; } } } } while (0)

struct XcdBarrier {
    int wave;
    unsigned* bar; unsigned x;
    volatile LAS unsigned* st;
};

__device__ __forceinline__ XcdBarrier xcd_barrier_post(unsigned* bar, volatile LAS unsigned* st, int wave) {
    XcdBarrier b; b.wave = wave; b.bar = bar; b.x = xb_xcc_id(); b.st = st;
    if (wave == 0 && lane_id() == 0) (void)xb_add(&bar[XB_XCNT(b.x)], 1u);
    return b;
}
__device__ __forceinline__ void xcd_barrier_complete(unsigned* bar, unsigned x, unsigned& nloc, unsigned& nx) {
    const unsigned G = gridDim.x * gridDim.y * gridDim.z;
    unsigned sum, cnt, mine, sp = 0u;
    for (;;) {
        sum = 0u; cnt = 0u; mine = 0u;
#pragma unroll
        for (unsigned j = 0; j < 16; ++j) { const unsigned c = xb_ld(&bar[XB_XCNT(j)]); sum += c; cnt += (c > 0u) ? 1u : 0u; mine = (j == x) ? c : mine; }
        if (sum == G) break;
        __builtin_amdgcn_s_sleep(1);
        if ((++sp & 255u) == 0u) { if (xb_ld(&bar[XB_TMO])) break; if (sp > XB_SPIN_CAP) { atomicAdd(&bar[XB_TMO], 1u); break; } }
    }
    nloc = mine > 0u ? mine : 1u; nx = cnt > 0u ? cnt : 1u;
}

__device__ __forceinline__ void xcd_barrier(const XcdBarrier& b) {
    asm volatile("s_waitcnt vmcnt(0)" ::: "memory");
    __syncthreads();
    if (b.wave == 0 && lane_id() == 0) {
        unsigned* bar = b.bar;
        __builtin_amdgcn_s_waitcnt(0);
        unsigned nloc = b.st[0], nx = b.st[1];
        if (nloc == 0u) { xcd_barrier_complete(bar, b.x, nloc, nx); b.st[0] = nloc; b.st[1] = nx; }
        const unsigned tgt = b.st[4] + nx; b.st[4] = tgt;
        const unsigned old = xb_add(&bar[XB_XSUB(b.x)], 1u);
        const unsigned gen = old / nloc;
        bool wait = true;
        if (old + 1u == (gen + 1u) * nloc) {
            __builtin_amdgcn_fence(__ATOMIC_RELEASE, "agent");
            asm volatile("s_waitcnt vmcnt(0)" ::: "memory");
            wait = xb_add(&bar[XB_TOP], 1u) + 1u != tgt;
        }
        if (wait) XB_SPIN(xb_ld(&bar[XB_TOP]) < tgt, bar);
        __builtin_amdgcn_fence(__ATOMIC_ACQUIRE, "agent");
        asm volatile("s_waitcnt vmcnt(0)" ::: "memory");
    }
    __syncthreads();
}
constexpr int NWAVES = 8, NTHR = 512;
constexpr int RING_BYTES = 131072;
constexpr int WSLICE = 19456;
constexpr int MISC_OFF = NWAVES * WSLICE;
constexpr int LDS_BYTES = MISC_OFF + 512;
static_assert(MISC_OFF >= RING_BYTES && LDS_BYTES <= 163840, "LDS map");
#define LDS_WAIT() asm volatile("s_waitcnt lgkmcnt(0)" ::: "memory")
#define VM_WAIT() asm volatile("s_waitcnt vmcnt(0)" ::: "memory")

struct Args { const void* in[25]; float* out; unsigned char* ws; int ph_lo, ph_hi, li, pad; };

constexpr int PH_PRO = 0, PH_KV = 1, PH_L0 = 2, PH_PER_LAYER = 13, PH_FINAL = PH_L0 + DEPTH * PH_PER_LAYER, PH_END = PH_FINAL + 1;
enum { LP_CONV = 0, LP_GUA, LP_DNA, LP_WIN, LP_MIXA, LP_SCAN, LP_MIXB, LP_WOUT, LP_XQ, LP_ATT, LP_XO, LP_GUB, LP_DNB };

DI void conv_item(const float* W, int ldw, int K, int NP, int nvalid, int mapk, const float* gk, bf16* WT, LAS float* scr, int item, int lane) {
    const int nblk = NP / 64, kb = item / nblk, nb = item % nblk, k0 = 64 * kb, n0 = 64 * nb;
    const int np = n0 + lane;
    int src = np; bool ok = np < nvalid;
    if (mapk == 1) { const int tile = np >> 8, t = np & 255; src = (t < 128) ? (128 * tile + t) : (DFF + 128 * tile + (t - 128)); ok = true; }
    const float* wp = W + (size_t)k0 * ldw + (ok ? src : 0);
#pragma unroll
    for (int h = 0; h < 2; ++h) { float w[32];
#pragma unroll
        for (int i = 0; i < 32; ++i) w[i] = wp[(size_t)(32 * h + i) * ldw];
#pragma unroll
        for (int i = 0; i < 32; ++i) { float v = ok ? w[i] : 0.f; if (gk) v *= gk[k0 + 32 * h + i]; scr[(32 * h + i) * 65 + lane] = v; } }
    LDS_WAIT();
    const int c = lane & 7;
#pragma unroll
    for (int j = 0; j < 8; ++j) { const int n = (lane >> 3) + 8 * j; const LAS float* s = scr + (8 * c) * 65 + n;
        u32x4 o; o.x = pk2(s[0 * 65], s[1 * 65]); o.y = pk2(s[2 * 65], s[3 * 65]); o.z = pk2(s[4 * 65], s[5 * 65]); o.w = pk2(s[6 * 65], s[7 * 65]);
        *(u32x4*)(WT + (size_t)(n0 + n) * K + k0 + 8 * c) = o; }
    LDS_WAIT();
}
DI int sel8(int j, int a0, int a1, int a2, int a3, int a4, int a5, int a6, int a7) { return j == 0 ? a0 : j == 1 ? a1 : j == 2 ? a2 : j == 3 ? a3 : j == 4 ? a4 : j == 5 ? a5 : j == 6 ? a6 : a7; }
DI const void* argp(const Args& a, int i) { asm volatile("" : "+s"(i)); return a.in[i]; }
enum { I_X = 0, I_MEM, I_POS, I_GFFA, I_WFFAGU, I_WFFADN, I_GMIX, I_WIN, I_GLAWA2, I_GLABA, I_GLAGN, I_RETGN, I_MLCONV, I_MLBI, I_MLBF, I_WOUT, I_GXA, I_GMEM, I_WXQ, I_WXKV, I_WXO, I_GFFB, I_WFFBGU, I_WFFBDN, I_GFINAL };
DI unsigned char* wl_base(const Args& args, int l) { return (l & 1) ? (unsigned char*)args.out : args.ws + WS_WL; }
DI void convert_layer(const Args& args, int l, LAS float* scr, int gw, int ngw, int lane) {
    constexpr int C_GU = (D / 64) * (2 * DFF / 64), C_DN = (DFF / 64) * (D / 64), C_IN = (D / 64) * (DINP / 64), C_SQ = (D / 64) * (D / 64);
    constexpr int NITEMS = 2 * C_GU + 2 * C_DN + C_IN + 3 * C_SQ;
    constexpr int cnt[8] = {C_GU, C_GU, C_DN, C_DN, C_IN, C_SQ, C_SQ, C_SQ};
    for (int it = gw; it < NITEMS; it += ngw) {
        int r = it, j = 0;
#pragma unroll
        for (int q = 0; q < 7; ++q) { if (j == q && r >= cnt[q]) { r -= cnt[q]; j = q + 1; } }
        const int in_idx = sel8(j, I_WFFAGU, I_WFFBGU, I_WFFADN, I_WFFBDN, I_WIN, I_WOUT, I_WXQ, I_WXO);
        const int g_idx = sel8(j, I_GFFA, I_GFFB, -1, -1, I_GMIX, -1, I_GXA, -1);
        const int ldw = sel8(j, 2 * DFF, 2 * DFF, D, D, DIN, D, D, D), K = sel8(j, D, D, DFF, DFF, D, D, D, D), NP = sel8(j, 2 * DFF, 2 * DFF, D, D, DINP, D, D, D);
        const int mapk = j < 2 ? 1 : 0;
        const size_t dst = j == 0 ? WL_GUA : j == 1 ? WL_GUB : j == 2 ? WL_DNA : j == 3 ? WL_DNB : j == 4 ? WL_IN : j == 5 ? WL_OUT : j == 6 ? WL_XQ : WL_XO;
        const float* W = (const float*)args.in[in_idx] + (size_t)l * K * ldw;
        const float* gk = g_idx >= 0 ? (const float*)args.in[g_idx >= 0 ? g_idx : 0] + l * D : nullptr;
        conv_item(W, ldw, K, NP, ldw, mapk, gk, (bf16*)(wl_base(args, l) + dst), scr, r, lane);
    }
}
DI void convert_kv(const Args& args, LAS float* scr, int gw, int ngw, int lane) {
    constexpr int C_KV = (D / 64) * (2048 / 64);
    const float* wkv = (const float*)argp(args, I_WXKV); const float* gm = (const float*)argp(args, I_GMEM);
    for (int it = gw; it < DEPTH * C_KV; it += ngw) { const int l = it / C_KV, r = it % C_KV;
        conv_item(wkv + (size_t)l * D * 2048, 2048, D, 2048, 2048, 0, gm + l * D, (bf16*)(args.ws + WS_WKV) + (size_t)l * 2048 * D, scr, r, lane); }
}
template <int RB>
DI void stats_rows(const float* x, bf16* xb, float* part, int m0, int mstep, int mend, int lane) {
    for (int m = m0; m < mend; m += RB * mstep) { f32x4 v[RB][4];
#pragma unroll
        for (int r = 0; r < RB; ++r) { const int mm = (m + r * mstep < mend) ? m + r * mstep : m; const f32x4* xr = (const f32x4*)(x + (size_t)mm * D);
#pragma unroll
            for (int j = 0; j < 4; ++j) v[r][j] = xr[lane + 64 * j]; }
#pragma unroll
        for (int r = 0; r < RB; ++r) { const int mm = m + r * mstep; float s = 0.f;
#pragma unroll
            for (int j = 0; j < 4; ++j) s += (v[r][j].x * v[r][j].x + v[r][j].y * v[r][j].y) + (v[r][j].z * v[r][j].z + v[r][j].w * v[r][j].w);
            s = wave_sum(s);
            if (mm < mend) {
#pragma unroll
                for (int j = 0; j < 4; ++j) { uint2 o; o.x = pk2(v[r][j].x, v[r][j].y); o.y = pk2(v[r][j].z, v[r][j].w); *(uint2*)(xb + (size_t)mm * D + (lane + 64 * j) * 4) = o; }
                if (lane < 16) part[(size_t)mm * 16 + lane] = (lane == 0) ? s : 0.f; } } }
}
#define GB_BASE    4096
#define GB_CNT(s)  (GB_BASE + 64 * (s))
#define GB_MASK(g) (GB_BASE + 4096 + 64 * (g))
static_assert(XCD_BAR_WORDS <= GB_BASE && (size_t)(GB_BASE + 4096 + 512) * 4 <= CTL_ZERO_BYTES, "control words");
DI void grp_post(const XcdBarrier& b) { if (b.wave == 0 && lane_id() == 0) (void)__hip_atomic_fetch_or(&b.bar[GB_MASK(blockIdx.x & 7u)], 1u << b.x, __ATOMIC_RELAXED, __HIP_MEMORY_SCOPE_AGENT); }
DI void grp_decide(const XcdBarrier& b, int G) {
    if (b.wave == 0 && lane_id() == 0) { unsigned ok = (G == 256) ? 1u : 0u;
        for (int g = 0; g < 8; ++g) { const unsigned m = xb_ld(&b.bar[GB_MASK(g)]); ok &= (m != 0u && (m & (m - 1u)) == 0u) ? 1u : 0u; }
        b.st[2] = ok ? 1u : 2u; }
    __syncthreads();
}
DI void grp_barrier(const XcdBarrier& b) {
    if (b.st[2] != 1u) { xcd_barrier(b); return; }
    asm volatile("s_waitcnt vmcnt(0)" ::: "memory");
    __syncthreads();
    if (b.wave == 0 && lane_id() == 0) {
        unsigned* cw = &b.bar[GB_CNT((blockIdx.x & 7u) * 8u + ((blockIdx.x >> 3) & 7u))];
        const unsigned tgt = b.st[3] + 4u; b.st[3] = tgt;
        __builtin_amdgcn_s_waitcnt(0);
        const unsigned old = xb_add(cw, 1u);
        if (old + 1u != tgt) XB_SPIN(xb_ld(cw) < tgt, b.bar);
        __builtin_amdgcn_fence(__ATOMIC_ACQUIRE, "agent");
        asm volatile("s_waitcnt vmcnt(0)" ::: "memory");
    }
    __syncthreads();
}
DI void loc_barrier(const XcdBarrier& b) {
    if (b.st[2] != 1u) { xcd_barrier(b); return; }
    asm volatile("s_waitcnt vmcnt(0)" ::: "memory");
    __syncthreads();
    if (b.wave == 0 && lane_id() == 0) { __builtin_amdgcn_fence(__ATOMIC_ACQUIRE, "agent"); asm volatile("s_waitcnt vmcnt(0)" ::: "memory"); }
    __syncthreads();
}
struct MixCtx { unsigned char* ws; const float *w_a2, *b_a, *gla_gn, *ret_gn, *conv, *b_i, *b_f; };
#ifndef MIXPROBE
#define MIXPROBE 0
#endif
#define LDS_FENCE() __builtin_amdgcn_fence(__ATOMIC_SEQ_CST, "wavefront", "local")
constexpr int NCH = SEQ / 64;
constexpr size_t ST_G = WS_ST, ST_R = WS_ST + 12 * MiB, ST_M = WS_ST + 24 * MiB, ST_GDEC = WS_ST + 41 * MiB, ST_MLSC = WS_ST + 42 * MiB;
constexpr int ML_BLK = 65 * 64;
static_assert(ST_M + (size_t)16 * NCH * ML_BLK * 2 <= ST_GDEC && ST_MLSC + (size_t)16 * NCH * 16 <= WS_Y, "state map");
constexpr float QK_SCALE32 = 0.17677669529663687f;

DI const bf16* prow(const bf16* P, size_t row) { return P + ((row >> 6) * (size_t)(DINP / 16) * 64 + (row & 63)) * 16; }
DI const bf16* pcol(const bf16* pr, int col) { return pr + (col >> 4) * 1024 + (col & 15); }
DI float blo(unsigned u) { return __uint_as_float(u << 16); }
DI float bhi(unsigned u) { return __uint_as_float(u & 0xffff0000u); }
DI void ld8(const bf16* p, float* o) { const uint4 v = *(const uint4*)p; o[0] = blo(v.x); o[1] = bhi(v.x); o[2] = blo(v.y); o[3] = bhi(v.y); o[4] = blo(v.z); o[5] = bhi(v.z); o[6] = blo(v.w); o[7] = bhi(v.w); }
DI f32x16 mfma32(bf16x8 a, bf16x8 b, f32x16 c) { return __builtin_amdgcn_mfma_f32_32x32x16_bf16(a, b, c, 0, 0, 0); }
DI bf16x8 lfrag(const LAS bf16* base, int ld, int row0, int k0, int lane) { return *(const LAS bf16x8*)(base + (row0 + (lane & 31)) * ld + k0 + 8 * (lane >> 5)); }
DI bf16x8 gfrag(const bf16* base, int ld, int row0, int k0, int lane) { return *(const bf16x8*)(base + (size_t)(row0 + (lane & 31)) * ld + k0 + 8 * (lane >> 5)); }
DI int crow(int reg, int hf) { return (reg & 3) + 8 * (reg >> 2) + 4 * hf; }
DI f32x16 zero16() { f32x16 z; for (int i = 0; i < 16; ++i) z[i] = 0.f; return z; }
template <int CTRL, int ROWMASK> DI float dpp_f(float old, float x) { return __builtin_bit_cast(float, __builtin_amdgcn_update_dpp(__builtin_bit_cast(int, old), __builtin_bit_cast(int, x), CTRL, ROWMASK, 0xf, false)); }
DI float scan_add(float x, int) {
    x += dpp_f<0x111, 0xf>(0.f, x); x += dpp_f<0x112, 0xf>(0.f, x); x += dpp_f<0x114, 0xf>(0.f, x); x += dpp_f<0x118, 0xf>(0.f, x);
    x += dpp_f<0x142, 0xa>(0.f, x); x += dpp_f<0x143, 0xc>(0.f, x);
    return x;
}
DI float scan_max(float x, int) {
    const float ninf = -__builtin_inff();
    x = fmaxf(x, dpp_f<0x111, 0xf>(ninf, x)); x = fmaxf(x, dpp_f<0x112, 0xf>(ninf, x)); x = fmaxf(x, dpp_f<0x114, 0xf>(ninf, x)); x = fmaxf(x, dpp_f<0x118, 0xf>(ninf, x));
    x = fmaxf(x, dpp_f<0x142, 0xa>(ninf, x)); x = fmaxf(x, dpp_f<0x143, 0xc>(ninf, x));
    return x;
}
DI u32x4 pk8(const float* v) { u32x4 w; w.x = pk2(v[0], v[1]); w.y = pk2(v[2], v[3]); w.z = pk2(v[4], v[5]); w.w = pk2(v[6], v[7]); return w; }
DI void stage_vt(const bf16* p, int col, LAS bf16* VT, int lane) {
#pragma unroll
    for (int q = 0; q < 8; ++q) { const uint4 w = *(const uint4*)pcol(p, col + 8 * q); const unsigned u[4] = {w.x, w.y, w.z, w.w};
#pragma unroll
        for (int e = 0; e < 4; ++e) { VT[(8 * q + 2 * e) * 72 + lane] = (bf16)(u[e] & 0xffffu); VT[(8 * q + 2 * e + 1) * 72 + lane] = (bf16)(u[e] >> 16); } }
}
DI void gla_logdecay(const float* w_a2, const float* b_a, int h, const bf16* p, float* la) {
    float ga[16]; ld8(pcol(p, C_GA), ga); ld8(pcol(p, C_GA + 8), ga + 8);
#pragma unroll
    for (int c = 0; c < 32; ++c) la[c] = b_a[h * 32 + c];
#pragma unroll
    for (int r = 0; r < 16; ++r)
#pragma unroll
        for (int c = 0; c < 32; ++c) la[c] += ga[r] * w_a2[r * 192 + h * 32 + c];
#pragma unroll
    for (int c = 0; c < 32; ++c) la[c] = logsigf_(la[c]) * (1.4426950408889634f / 16.f);
}
DI void rot_row(const bf16* p, int col, const float2* cs, float scale, float* o) {
    float x[32];
#pragma unroll
    for (int q = 0; q < 4; ++q) ld8(pcol(p, col + 8 * q), x + 8 * q);
#pragma unroll
    for (int m = 0; m < 16; ++m) { const float2 c = cs[m]; o[m] = (x[m] * c.x - x[m + 16] * c.y) * scale; o[m + 16] = (x[m] * c.y + x[m + 16] * c.x) * scale; }
}

template <bool RET>
DI void gr_passA(const MixCtx& cx, int b, int h, int ch, LAS unsigned char* sl, int lane) {
    const int t = ch * 64 + lane; const size_t row = (size_t)b * SEQ + t; const bf16* p = prow((const bf16*)(cx.ws + WS_P), row);
    LAS bf16* KT = (LAS bf16*)sl; LAS bf16* VT = (LAS bf16*)(sl + 9216);
    const int item = (b * 6 + h) * NCH + ch;
    float k[32];
    if (!RET) {
        float bc[32];
        gla_logdecay(cx.w_a2, cx.b_a, h, p, bc);
#pragma unroll
        for (int c = 0; c < 32; ++c) bc[c] = scan_add(bc[c], lane);
#pragma unroll
        for (int q = 0; q < 4; ++q) ld8(pcol(p, C_GK + h * 32 + 8 * q), k + 8 * q);
#pragma unroll
        for (int c = 0; c < 32; ++c) { const float bl = __shfl(bc[c], 63); k[c] *= __builtin_amdgcn_exp2f(bl - bc[c]); bc[c] = __builtin_amdgcn_exp2f(bl); }
        if (lane == 0) { float* gd = (float*)(cx.ws + ST_GDEC) + (size_t)item * 32;
#pragma unroll
            for (int q = 0; q < 8; ++q) *(f32x4*)(gd + 4 * q) = (f32x4){bc[4 * q], bc[4 * q + 1], bc[4 * q + 2], bc[4 * q + 3]}; }
    } else {
        const float lg = __logf(1.f - exp2f(-5.f - (float)h));
        rot_row(p, C_RK + h * 32, (const float2*)(cx.ws + WS_ROPE) + row * 16, QK_SCALE32 * __expf((float)(63 - lane) * lg), k);
    }
#pragma unroll
    for (int c = 0; c < 32; ++c) KT[c * 72 + lane] = f2bf(k[c]);
    stage_vt(p, (RET ? C_RV : C_GV) + h * 64, VT, lane);
    LDS_FENCE();
    f32x16 a0 = zero16(), a1 = zero16();
#pragma unroll
    for (int ks = 0; ks < 4; ++ks) { const bf16x8 bk = lfrag(KT, 72, 0, ks * 16, lane);
        a0 = mfma32(lfrag(VT, 72, 0, ks * 16, lane), bk, a0); a1 = mfma32(lfrag(VT, 72, 32, ks * 16, lane), bk, a1); }
    bf16* st = (bf16*)(cx.ws + (RET ? ST_R : ST_G)) + (size_t)item * 2048;
    const int hf = lane >> 5, r32 = lane & 31;
#pragma unroll
    for (int r = 0; r < 16; ++r) { st[crow(r, hf) * 32 + r32] = f2bf(a0[r]); st[(32 + crow(r, hf)) * 32 + r32] = f2bf(a1[r]); }
    LDS_FENCE();
}

template <bool RET, int STOP = 0>
DI void gr_passB(const MixCtx& cx, int b, int h, int ch, LAS unsigned char* sl, int lane) {
    const int t = ch * 64 + lane; const size_t row = (size_t)b * SEQ + t; const bf16* p = prow((const bf16*)(cx.ws + WS_P), row);
    LAS bf16* QS = (LAS bf16*)sl; LAS bf16* KS = (LAS bf16*)(sl + 4096); LAS bf16* VT = (LAS bf16*)(sl + 9216); LAS bf16* PS = (LAS bf16*)sl; LAS float* OS = (LAS float*)sl;
    const int item = (b * 6 + h) * NCH + ch; const int hf = lane >> 5, r32 = lane & 31;
    const bf16* st = (const bf16*)(cx.ws + (RET ? ST_R : ST_G)) + (size_t)item * 2048;
    bf16x8 gst[2][2]; u32x4 gq[8];
#pragma unroll
    for (int ks = 0; ks < 2; ++ks) { gst[0][ks] = gfrag(st, 32, 0, ks * 16, lane); gst[1][ks] = gfrag(st, 32, 32, ks * 16, lane); }
#pragma unroll
    for (int q = 0; q < 8; ++q) gq[q] = *(const u32x4*)pcol(p, (RET ? C_RG : C_GR) + h * 64 + 8 * q);
    stage_vt(p, (RET ? C_RV : C_GV) + h * 64, VT, lane);
    {
        float q[32], k[32];
        if (!RET) {
            float bc[32];
            gla_logdecay(cx.w_a2, cx.b_a, h, p, bc);
    #pragma unroll
        for (int c = 0; c < 32; ++c) bc[c] = scan_add(bc[c], lane);
#pragma unroll
            for (int qq = 0; qq < 4; ++qq) { ld8(pcol(p, C_GQ + h * 32 + 8 * qq), q + 8 * qq); ld8(pcol(p, C_GK + h * 32 + 8 * qq), k + 8 * qq); }
#pragma unroll
            for (int c = 0; c < 32; ++c) { q[c] *= QK_SCALE32 * __builtin_amdgcn_exp2f(bc[c]); k[c] *= __builtin_amdgcn_exp2f(-bc[c]); }
        } else {
            const float lg = __logf(1.f - exp2f(-5.f - (float)h)); const float2* cs = (const float2*)(cx.ws + WS_ROPE) + row * 16;
            rot_row(p, C_RQ + h * 32, cs, __expf((float)(lane + 1) * lg), q);
            rot_row(p, C_RK + h * 32, cs, QK_SCALE32 * __expf(-(float)(lane + 1) * lg), k);
        }
#pragma unroll
        for (int qq = 0; qq < 4; ++qq) { *(LAS u32x4*)(QS + lane * 32 + 8 * qq) = pk8(q + 8 * qq); *(LAS u32x4*)(KS + lane * 32 + 8 * qq) = pk8(k + 8 * qq); }
    }
    LDS_FENCE();
    if (STOP == 1) return;
    f32x16 s00 = zero16(), s10 = zero16(), s11 = zero16();
    bf16x8 qa[2][2];
#pragma unroll
    for (int ks = 0; ks < 2; ++ks) {
        qa[0][ks] = lfrag(QS, 32, 0, ks * 16, lane); qa[1][ks] = lfrag(QS, 32, 32, ks * 16, lane);
        const bf16x8 b0 = lfrag(KS, 32, 0, ks * 16, lane), b1 = lfrag(KS, 32, 32, ks * 16, lane);
        s00 = mfma32(qa[0][ks], b0, s00); s10 = mfma32(qa[1][ks], b0, s10); s11 = mfma32(qa[1][ks], b1, s11);
    }
    LDS_FENCE();
#pragma unroll
    for (int r = 0; r < 16; ++r) { const int i0 = crow(r, hf); const bool keep = r32 <= i0;
        PS[i0 * 72 + r32] = f2bf(keep ? s00[r] : 0.f); PS[(32 + i0) * 72 + r32] = f2bf(s10[r]); PS[(32 + i0) * 72 + 32 + r32] = f2bf(keep ? s11[r] : 0.f); }
    f32x16 o00 = zero16(), o01 = zero16(), o10 = zero16(), o11 = zero16();
#pragma unroll
    for (int ks = 0; ks < 2; ++ks) { const bf16x8 g0 = gst[0][ks], g1 = gst[1][ks];
        o00 = mfma32(qa[0][ks], g0, o00); o01 = mfma32(qa[0][ks], g1, o01); o10 = mfma32(qa[1][ks], g0, o10); o11 = mfma32(qa[1][ks], g1, o11); }
    LDS_FENCE();
    if (STOP == 2) { asm volatile("" :: "v"(o00[0] + o01[0] + o10[0] + o11[0])); return; }
#pragma unroll
    for (int ks = 0; ks < 4; ++ks) { const bf16x8 v0 = lfrag(VT, 72, 0, ks * 16, lane), v1 = lfrag(VT, 72, 32, ks * 16, lane);
        if (ks < 2) { const bf16x8 a0 = lfrag(PS, 72, 0, ks * 16, lane); o00 = mfma32(a0, v0, o00); o01 = mfma32(a0, v1, o01); }
        const bf16x8 a1 = lfrag(PS, 72, 32, ks * 16, lane); o10 = mfma32(a1, v0, o10); o11 = mfma32(a1, v1, o11); }
    LDS_FENCE();
#pragma unroll
    for (int r = 0; r < 16; ++r) { const int i0 = crow(r, hf); OS[i0 * 68 + r32] = o00[r]; OS[i0 * 68 + 32 + r32] = o01[r]; OS[(32 + i0) * 68 + r32] = o10[r]; OS[(32 + i0) * 68 + 32 + r32] = o11[r]; }
    LDS_FENCE();
    float o[64];
#pragma unroll
    for (int q = 0; q < 16; ++q) { const f32x4 v = *(const LAS f32x4*)(OS + lane * 68 + 4 * q); o[4 * q] = v.x; o[4 * q + 1] = v.y; o[4 * q + 2] = v.z; o[4 * q + 3] = v.w; }
    float mu = 0.f, ss = 0.f;
    if (RET) {
#pragma unroll
        for (int c = 0; c < 64; ++c) mu += o[c];
        mu *= (1.f / 64.f); }
#pragma unroll
    for (int c = 0; c < 64; ++c) { o[c] -= mu; ss += o[c] * o[c]; }
    const float rn = rsqrtf(ss * (1.f / 64.f) + EPS);
    const float* gn = (RET ? cx.ret_gn : cx.gla_gn) + h * 64;
    bf16* yp = (bf16*)(cx.ws + WS_Y) + row * D + (RET ? 384 : 0) + h * 64;
#pragma unroll
    for (int q = 0; q < 8; ++q) { float y[8]; const float g[8] = {blo(gq[q].x), bhi(gq[q].x), blo(gq[q].y), bhi(gq[q].y), blo(gq[q].z), bhi(gq[q].z), blo(gq[q].w), bhi(gq[q].w)};
#pragma unroll
        for (int e = 0; e < 8; ++e) y[e] = o[8 * q + e] * rn * gn[8 * q + e] * siluf_(g[e]);
        *(u32x4*)(yp + 8 * q) = pk8(y); }
    LDS_FENCE();
}

template <int NC>
DI void ml_conv_row(const bf16* P, size_t row, int t, int col, const float* w, int wch, float scale, float* o) {
    u32x4 x[4][NC / 8];
    const bool first = __builtin_amdgcn_readfirstlane(t) < 64;
#pragma unroll
    for (int j = 0; j < 4; ++j) { const bf16* pp = prow(P, (first && t - 3 + j < 0) ? row : row - 3 + j);
#pragma unroll
        for (int q = 0; q < NC / 8; ++q) x[j][q] = *(const u32x4*)pcol(pp, col + 8 * q); }
    if (first) {
#pragma unroll
        for (int j = 0; j < 3; ++j) { if (t - 3 + j < 0) {
#pragma unroll
                for (int q = 0; q < NC / 8; ++q) x[j][q] = (u32x4){0u, 0u, 0u, 0u}; } } }
#pragma unroll
    for (int c = 0; c < NC; ++c) o[c] = 0.f;
#pragma unroll
    for (int j = 0; j < 4; ++j)
#pragma unroll
        for (int q = 0; q < NC / 8; ++q) { const u32x4 v = x[j][q]; const float* wj = w + j * 512 + wch + 8 * q;
            o[8 * q + 0] += wj[0] * blo(v.x); o[8 * q + 1] += wj[1] * bhi(v.x); o[8 * q + 2] += wj[2] * blo(v.y); o[8 * q + 3] += wj[3] * bhi(v.y);
            o[8 * q + 4] += wj[4] * blo(v.z); o[8 * q + 5] += wj[5] * bhi(v.z); o[8 * q + 6] += wj[6] * blo(v.w); o[8 * q + 7] += wj[7] * bhi(v.w); }
#pragma unroll
    for (int c = 0; c < NC; ++c) o[c] = siluf_(o[c]) * scale;
}
DI void ml_passA(const MixCtx& cx, int b, int h, int ch, LAS unsigned char* sl, int lane) {
    const int t = ch * 64 + lane; const size_t row = (size_t)b * SEQ + t; const bf16* P = (const bf16*)(cx.ws + WS_P); const bf16* p = prow(P, row);
    LAS bf16* KT = (LAS bf16*)sl; LAS bf16* VT = (LAS bf16*)(sl + 9216);
    const int item = (b * 4 + h) * NCH + ch; const int hf = lane >> 5, r32 = lane & 31;
    const float ii = bf2f(*pcol(p, C_MI + h)) + cx.b_i[h];
    const float lf = logsigf_(bf2f(*pcol(p, C_MF + h)) + cx.b_f[h]);
    const float bcum = scan_add(lf, lane), blast = __shfl(bcum, 63);
    const float lw = blast - bcum + ii, mloc = wave_max(lw), wgt = __expf(lw - mloc);
#pragma unroll
    for (int hh = 0; hh < 2; ++hh) {
        float k[32];
        ml_conv_row<32>(P, row, t, C_MK + h * 64 + 32 * hh, cx.conv, 256 + h * 64 + 32 * hh, 0.125f * wgt, k);
#pragma unroll
        for (int c = 0; c < 32; ++c) KT[(32 * hh + c) * 72 + lane] = f2bf(k[c]);
    }
    stage_vt(p, C_MV + h * 64, VT, lane);
    LDS_FENCE();
    f32x16 c00 = zero16(), c01 = zero16(), c10 = zero16(), c11 = zero16();
#pragma unroll
    for (int ks = 0; ks < 4; ++ks) { const bf16x8 a0 = lfrag(VT, 72, 0, ks * 16, lane), a1 = lfrag(VT, 72, 32, ks * 16, lane), b0 = lfrag(KT, 72, 0, ks * 16, lane), b1 = lfrag(KT, 72, 32, ks * 16, lane);
        c00 = mfma32(a0, b0, c00); c01 = mfma32(a0, b1, c01); c10 = mfma32(a1, b0, c10); c11 = mfma32(a1, b1, c11); }
    bf16* st = (bf16*)(cx.ws + ST_M) + (size_t)item * ML_BLK;
#pragma unroll
    for (int r = 0; r < 16; ++r) { const int v0 = crow(r, hf);
        st[v0 * 64 + r32] = f2bf(c00[r]); st[v0 * 64 + 32 + r32] = f2bf(c01[r]); st[(32 + v0) * 64 + r32] = f2bf(c10[r]); st[(32 + v0) * 64 + 32 + r32] = f2bf(c11[r]); }
    { float s = 0.f;
#pragma unroll
      for (int q = 0; q < 8; ++q) { const u32x4 w = *(const LAS u32x4*)(KT + lane * 72 + 8 * q); s += (blo(w.x) + bhi(w.x)) + (blo(w.y) + bhi(w.y)) + (blo(w.z) + bhi(w.z)) + (blo(w.w) + bhi(w.w)); }
      st[64 * 64 + lane] = f2bf(s); }
    if (lane == 0) { float* sc = (float*)(cx.ws + ST_MLSC) + (size_t)item * 4; sc[0] = blast; sc[1] = mloc; }
    LDS_FENCE();
}
template <int STOP = 0>
DI void ml_passB(const MixCtx& cx, int b, int h, int ch, LAS unsigned char* sl, int lane) {
    const int t = ch * 64 + lane; const size_t row = (size_t)b * SEQ + t; const bf16* P = (const bf16*)(cx.ws + WS_P); const bf16* p = prow(P, row);
    LAS bf16* R1 = (LAS bf16*)sl; LAS bf16* R2 = (LAS bf16*)(sl + 9216); LAS float* OS = (LAS float*)sl;
    const int item = (b * 4 + h) * NCH + ch; const int hf = lane >> 5, r32 = lane & 31;
    const float* cw = cx.conv;
    const bf16* st = (const bf16*)(cx.ws + ST_M) + (size_t)item * ML_BLK;
    const float mst = ((const float*)(cx.ws + ST_MLSC))[(size_t)item * 4 + 2];
    const float ii = bf2f(*pcol(p, C_MI + h)) + cx.b_i[h];
    const float lf = logsigf_(bf2f(*pcol(p, C_MF + h)) + cx.b_f[h]);
    const float bcum = scan_add(lf, lane);
    const float u = ii - bcum, pm = scan_max(u, lane), U = __shfl(pm, 63);
    const float mx = fmaxf(mst, pm), mi = bcum + mx, winter = __expf(mst - mx), Ai = __expf(U - mx), Bj = __expf(u - U);
    float den = 0.f;
#pragma unroll
    for (int hh = 0; hh < 2; ++hh) {
        float q[32];
        ml_conv_row<32>(P, row, t, C_MQ + h * 64 + 32 * hh, cw, h * 64 + 32 * hh, 1.f, q);
#pragma unroll
        for (int qq = 0; qq < 4; ++qq) { float n[8], a[8], w[8]; ld8(st + 64 * 64 + 32 * hh + 8 * qq, n);
#pragma unroll
            for (int e = 0; e < 8; ++e) { den += q[8 * qq + e] * n[e]; w[e] = q[8 * qq + e] * winter; a[e] = q[8 * qq + e] * Ai; }
            *(LAS u32x4*)(R1 + lane * 72 + 32 * hh + 8 * qq) = pk8(w); *(LAS u32x4*)(R2 + lane * 72 + 32 * hh + 8 * qq) = pk8(a); }
    }
    den *= winter;
    LDS_FENCE();
    if (STOP == 1) { asm volatile("" :: "v"(den)); return; }
    bf16x8 qw[2][4];
#pragma unroll
    for (int ks = 0; ks < 4; ++ks) { qw[0][ks] = lfrag(R1, 72, 0, ks * 16, lane); qw[1][ks] = lfrag(R1, 72, 32, ks * 16, lane); }
    LDS_FENCE();
#pragma unroll
    for (int hh = 0; hh < 4; ++hh) {
        float k[16];
        ml_conv_row<16>(P, row, t, C_MK + h * 64 + 16 * hh, cw, 256 + h * 64 + 16 * hh, 0.125f * Bj, k);
#pragma unroll
        for (int qq = 0; qq < 2; ++qq) *(LAS u32x4*)(R1 + lane * 72 + 16 * hh + 8 * qq) = pk8(k + 8 * qq);
    }
    LDS_FENCE();
    f32x16 s00 = zero16(), s10 = zero16(), s11 = zero16();
#pragma unroll
    for (int ks = 0; ks < 4; ++ks) { const bf16x8 a0 = lfrag(R2, 72, 0, ks * 16, lane), a1 = lfrag(R2, 72, 32, ks * 16, lane), b0 = lfrag(R1, 72, 0, ks * 16, lane), b1 = lfrag(R1, 72, 32, ks * 16, lane);
        s00 = mfma32(a0, b0, s00); s10 = mfma32(a1, b0, s10); s11 = mfma32(a1, b1, s11); }
    LDS_FENCE();
#pragma unroll
    for (int r = 0; r < 16; ++r) { const int i0 = crow(r, hf); const bool keep = r32 <= i0;
        R1[i0 * 72 + r32] = f2bf(keep ? s00[r] : 0.f); R1[i0 * 72 + 32 + r32] = 0; R1[(32 + i0) * 72 + r32] = f2bf(s10[r]); R1[(32 + i0) * 72 + 32 + r32] = f2bf(keep ? s11[r] : 0.f); }
    f32x16 o00 = zero16(), o01 = zero16(), o10 = zero16(), o11 = zero16();
#pragma unroll
    for (int ks = 0; ks < 4; ++ks) { const bf16x8 g0 = gfrag(st, 64, 0, ks * 16, lane), g1 = gfrag(st, 64, 32, ks * 16, lane);
        o00 = mfma32(qw[0][ks], g0, o00); o01 = mfma32(qw[0][ks], g1, o01); o10 = mfma32(qw[1][ks], g0, o10); o11 = mfma32(qw[1][ks], g1, o11); }
    if (STOP == 2) { asm volatile("" :: "v"(o00[0] + o01[0] + o10[0] + o11[0] + den)); return; }
    stage_vt(p, C_MV + h * 64, R2, lane);
    LDS_FENCE();
    { float s = 0.f;
#pragma unroll
      for (int q = 0; q < 8; ++q) { const u32x4 w = *(const LAS u32x4*)(R1 + lane * 72 + 8 * q); s += (blo(w.x) + bhi(w.x)) + (blo(w.y) + bhi(w.y)) + (blo(w.z) + bhi(w.z)) + (blo(w.w) + bhi(w.w)); }
      den += s; }
#pragma unroll
    for (int ks = 0; ks < 4; ++ks) { const bf16x8 v0 = lfrag(R2, 72, 0, ks * 16, lane), v1 = lfrag(R2, 72, 32, ks * 16, lane);
        if (ks < 2) { const bf16x8 a0 = lfrag(R1, 72, 0, ks * 16, lane); o00 = mfma32(a0, v0, o00); o01 = mfma32(a0, v1, o01); }
        const bf16x8 a1 = lfrag(R1, 72, 32, ks * 16, lane); o10 = mfma32(a1, v0, o10); o11 = mfma32(a1, v1, o11); }
    LDS_FENCE();
#pragma unroll
    for (int r = 0; r < 16; ++r) { const int i0 = crow(r, hf); OS[i0 * 68 + r32] = o00[r]; OS[i0 * 68 + 32 + r32] = o01[r]; OS[(32 + i0) * 68 + r32] = o10[r]; OS[(32 + i0) * 68 + 32 + r32] = o11[r]; }
    LDS_FENCE();
    const float inv = __builtin_amdgcn_rcpf(fmaxf(fabsf(den), __expf(-mi)));
    const int gcol = C_MO + h * 64; bf16* yp = (bf16*)(cx.ws + WS_Y) + row * D + 768 + h * 64;
#pragma unroll
    for (int q = 0; q < 8; ++q) { float g[8], y[8]; ld8(pcol(p, gcol + 8 * q), g);
        const f32x4 oa = *(const LAS f32x4*)(OS + lane * 68 + 8 * q), ob = *(const LAS f32x4*)(OS + lane * 68 + 8 * q + 4); const float o8[8] = {oa.x, oa.y, oa.z, oa.w, ob.x, ob.y, ob.z, ob.w};
#pragma unroll
        for (int e = 0; e < 8; ++e) y[e] = o8[e] * inv * sigmoidf_(g[e]);
        *(u32x4*)(yp + 8 * q) = pk8(y); }
    LDS_FENCE();
}

DI bool mix_item(int k, int wave, int G, int& hs, int& b, int& ch) {
    const int rnd = k >> 2, j = (((k & 3) + wave + (wave >> 2)) & 3) * 8 + wave;
    int t, h0, nh; if (j < 12) { t = j; h0 = 0; nh = 6; } else if (j < 24) { t = j - 12; h0 = 6; nh = 6; } else { t = j - 24; h0 = 12; nh = 4; }
    const int grp = (rnd * G + (int)blockIdx.x) * 2 + t / nh;
    if (grp >= BATCH * NCH) return false;
    hs = h0 + t % nh; b = grp & 3; ch = grp >> 2; return true;
}
DI void mix_passA(const MixCtx& cx, LAS unsigned char* sl, int wave, int G, int lane) {
    for (int k = 0; ; ++k) { int hs, b, ch; if (!mix_item(k, wave, G, hs, b, ch)) break; asm volatile("" : "+v"(lane));
        if (hs < 6) gr_passA<false>(cx, b, hs, ch, sl, lane); else if (hs < 12) gr_passA<true>(cx, b, hs - 6, ch, sl, lane); else ml_passA(cx, b, hs - 12, ch, sl, lane); }
}
DI void mix_passB(const MixCtx& cx, LAS unsigned char* sl, int wave, int G, int lane) {
    for (int k = 0; ; ++k) { int hs, b, ch; if (!mix_item(k, wave, G, hs, b, ch)) break; asm volatile("" : "+v"(lane));
        if (hs < 6) gr_passB<false>(cx, b, hs, ch, sl, lane); else if (hs < 12) gr_passB<true>(cx, b, hs - 6, ch, sl, lane); else ml_passB(cx, b, hs - 12, ch, sl, lane); }
}
DI void mix_scan(const MixCtx& cx, int gtid, int nthr) {
    constexpr int T_GR = 24 * 1024, T_ML = 16 * (ML_BLK / 2);
    for (int task = gtid; task < 2 * T_GR + T_ML; task += nthr) {
        if (task < 2 * T_GR) {
            const bool ret = task >= T_GR; const int tt = ret ? task - T_GR : task; const int seq = tt >> 10, w = tt & 1023;
            unsigned* base = (unsigned*)(cx.ws + (ret ? ST_R : ST_G)) + (size_t)seq * NCH * 1024 + w;
            const float* gd = (const float*)(cx.ws + ST_GDEC) + (size_t)seq * NCH * 32 + ((2 * w) & 31);
            const float gr = __expf(64.f * __logf(1.f - exp2f(-5.f - (float)(seq % 6))));
            float s0 = 0.f, s1 = 0.f;
            for (int c0 = 0; c0 < NCH; c0 += 32) { unsigned dv[32]; float g0[32], g1[32];
#pragma unroll
                for (int j = 0; j < 32; ++j) { dv[j] = base[(size_t)(c0 + j) * 1024]; if (ret) { g0[j] = gr; g1[j] = gr; } else { g0[j] = gd[(c0 + j) * 32]; g1[j] = gd[(c0 + j) * 32 + 1]; } }
#pragma unroll
                for (int j = 0; j < 32; ++j) { base[(size_t)(c0 + j) * 1024] = pk2(s0, s1); s0 = g0[j] * s0 + blo(dv[j]); s1 = g1[j] * s1 + bhi(dv[j]); } }
        } else {
            const int tt = task - 2 * T_GR; const int seq = tt / (ML_BLK / 2), w = tt % (ML_BLK / 2);
            unsigned* base = (unsigned*)(cx.ws + ST_M) + (size_t)seq * NCH * (ML_BLK / 2) + w; float* sc = (float*)(cx.ws + ST_MLSC) + (size_t)seq * NCH * 4;
            float m = 0.f, c0v = 0.f, c1v = 0.f;
            for (int c0 = 0; c0 < NCH; c0 += 32) { unsigned dv[32]; float bl[32], ml[32];
#pragma unroll
                for (int j = 0; j < 32; ++j) { dv[j] = base[(size_t)(c0 + j) * (ML_BLK / 2)]; bl[j] = sc[(c0 + j) * 4]; ml[j] = sc[(c0 + j) * 4 + 1]; }
#pragma unroll
                for (int j = 0; j < 32; ++j) { base[(size_t)(c0 + j) * (ML_BLK / 2)] = pk2(c0v, c1v); if (w == 0) sc[(c0 + j) * 4 + 2] = m;
                    const float mn = fmaxf(bl[j] + m, ml[j]), g = __expf(bl[j] + m - mn), s = __expf(ml[j] - mn);
                    c0v = g * c0v + s * blo(dv[j]); c1v = g * c1v + s * bhi(dv[j]); m = mn; } }
        }
    }
}

constexpr int ATT_LD = 264;
static_assert(256 * ATT_LD * 2 <= MISC_OFF, "attention image fits under the LDS control words");
typedef unsigned u32x2 __attribute__((ext_vector_type(2)));
typedef float f32x2_t __attribute__((ext_vector_type(2)));
typedef __bf16 bf16x2_t __attribute__((ext_vector_type(2)));
DI unsigned cvtpk(float lo, float hi) { const f32x2_t v = {lo, hi}; const bf16x2_t b = __builtin_convertvector(v, bf16x2_t); return __builtin_bit_cast(unsigned, b); }
template <int NB>
DI void att_stage(const bf16* src, size_t src_pitch, LAS bf16* img, int tid) {
#pragma unroll
    for (int b0 = 0; b0 < 16; b0 += NB) { u32x4 v[NB];
#pragma unroll
        for (int it = 0; it < NB; ++it) { const int c = tid + 512 * (b0 + it), r = c >> 5, part = c & 31; v[it] = *(const u32x4*)(src + (size_t)r * src_pitch + part * 8); }
#pragma unroll
        for (int it = 0; it < NB; ++it) { const int c = tid + 512 * (b0 + it), r = c >> 5, part = c & 31; *(LAS u32x4*)(img + r * ATT_LD + part * 8) = v[it]; } }
}
DI void attn_phase(unsigned char* ws, int l, LAS unsigned char* lds, int G, int tid, const int wave) {
    LAS bf16* img = (LAS bf16*)lds;
    const bf16* Q = (const bf16*)(ws + WS_Q); bf16* O = (bf16*)(ws + WS_O);
    const bf16* KBl = (const bf16*)(ws + WS_KB) + (size_t)l * 1024 * 1024; const bf16* VTl = (const bf16*)(ws + WS_VT) + (size_t)l * 4 * 1024 * 256;
    const int gx = blockIdx.x & 7, nj = G >> 3;
    if (wave & 4) __builtin_amdgcn_s_setprio(1);
    for (int j = blockIdx.x >> 3; j < 64; j += nj) {
        asm volatile("" : "+v"(tid)); const int lane = tid & 63, hf = lane >> 5, r32 = lane & 31;
        const int pm = gx * 16 + (j >> 5) * 8 + (j & 7), hd = (j >> 3) & 3, qt = pm & 31, b = pm >> 5;
        const size_t m0 = (size_t)b * SEQ + qt * 256 + wave * 32;
        const bf16* qb = Q + m0 * D + hd * 256;
        bf16x8 qa[4];
#pragma unroll
        for (int i = 0; i < 4; ++i) qa[i] = gfrag(qb, D, 0, i * 16, lane);
        att_stage<16>(KBl + ((size_t)b * 256) * 1024 + hd * 256, 1024, img, tid);
        __syncthreads();
        f32x16 sa[8];
#pragma unroll
        for (int kt = 0; kt < 8; ++kt) sa[kt] = zero16();
        bf16x8 ka[4], kb[4];
#pragma unroll
        for (int kt = 0; kt < 4; ++kt) ka[kt] = lfrag(img, ATT_LD, kt * 32, 0, lane);
#pragma unroll 1
        for (int g = 0; g < 4; ++g) { bf16x8 qn[4]; const int gn = g < 3 ? g + 1 : 3;
#pragma unroll
            for (int i = 0; i < 4; ++i) qn[i] = gfrag(qb, D, 0, (4 * gn + i) * 16, lane);
#pragma unroll
            for (int i = 0; i < 4; ++i) { const int ks = 4 * g + i, ksn = (ks + 1) & 15;
#pragma unroll
                for (int kt = 0; kt < 4; ++kt) kb[kt] = lfrag(img, ATT_LD, (4 + kt) * 32, ks * 16, lane);
                __builtin_amdgcn_sched_barrier(0);
#pragma unroll
                for (int kt = 0; kt < 4; ++kt) sa[kt] = mfma32(ka[kt], qa[i], sa[kt]);
                __builtin_amdgcn_sched_barrier(0);
#pragma unroll
                for (int kt = 0; kt < 4; ++kt) ka[kt] = lfrag(img, ATT_LD, kt * 32, ksn * 16, lane);
                __builtin_amdgcn_sched_barrier(0);
#pragma unroll
                for (int kt = 0; kt < 4; ++kt) sa[4 + kt] = mfma32(kb[kt], qa[i], sa[4 + kt]);
                __builtin_amdgcn_sched_barrier(0); }
#pragma unroll
            for (int i = 0; i < 4; ++i) qa[i] = qn[i]; }
        float mx = -3.0e38f;
#pragma unroll
        for (int kt = 0; kt < 8; ++kt)
#pragma unroll
            for (int r = 0; r < 16; ++r) mx = fmaxf(mx, sa[kt][r]);
        mx = fmaxf(mx, __shfl_xor(mx, 32));
        float sum = 0.f; unsigned pf[8][2][4];
#pragma unroll
        for (int kt = 0; kt < 8; ++kt) {
#pragma unroll
            for (int r = 0; r < 16; ++r) { sa[kt][r] = __builtin_amdgcn_exp2f(sa[kt][r] - mx); sum += sa[kt][r]; }
#pragma unroll
            for (int s = 0; s < 2; ++s)
#pragma unroll
                for (int j = 0; j < 4; ++j) pf[kt][s][j] = cvtpk(sa[kt][8 * s + 2 * j], sa[kt][8 * s + 2 * j + 1]); }
        sum += __shfl_xor(sum, 32);
        const float inv = __builtin_amdgcn_rcpf(sum);
        __syncthreads();
        att_stage<8>(VTl + ((size_t)b * 1024 + hd * 256) * 256, 256, img, tid);
        __syncthreads();
        f32x16 oa[8];
#pragma unroll
        for (int vt = 0; vt < 8; ++vt) oa[vt] = zero16();
        const LAS bf16* vbase = img + r32 * ATT_LD + 8 * hf;
        bf16x8 va[4], vb[4];
#pragma unroll
        for (int vt = 0; vt < 4; ++vt) va[vt] = *(const LAS bf16x8*)(vbase + vt * 32 * ATT_LD);
#pragma unroll
        for (int st = 0; st < 16; ++st) { const int kt = st >> 1, s = st & 1, sn = (st + 1) & 15;
            u32x4 pa; pa.x = pf[kt][s][0]; pa.y = pf[kt][s][1]; pa.z = pf[kt][s][2]; pa.w = pf[kt][s][3];
            const bf16x8 a = __builtin_bit_cast(bf16x8, pa);
#pragma unroll
            for (int vt = 0; vt < 4; ++vt) vb[vt] = *(const LAS bf16x8*)(vbase + (4 + vt) * 32 * ATT_LD + st * 16);
            __builtin_amdgcn_sched_barrier(0);
#pragma unroll
            for (int vt = 0; vt < 4; ++vt) oa[vt] = mfma32(a, va[vt], oa[vt]);
            __builtin_amdgcn_sched_barrier(0);
#pragma unroll
            for (int vt = 0; vt < 4; ++vt) va[vt] = *(const LAS bf16x8*)(vbase + vt * 32 * ATT_LD + sn * 16);
            __builtin_amdgcn_sched_barrier(0);
#pragma unroll
            for (int vt = 0; vt < 4; ++vt) oa[4 + vt] = mfma32(a, vb[vt], oa[4 + vt]);
            __builtin_amdgcn_sched_barrier(0); }
        bf16* ob = O + m0 * D + hd * 256;
#pragma unroll
        for (int r = 0; r < 16; ++r) { const int i0 = crow(r, hf); const float sc = __shfl(inv, i0);
#pragma unroll
            for (int vt = 0; vt < 8; ++vt) ob[(size_t)i0 * D + vt * 32 + r32] = f2bf(oa[vt][r] * sc); }
        __syncthreads();
    }
    __builtin_amdgcn_s_setprio(0);
}
DI void final_phase(const Args& args, int gw, int ngw, int lane) {
    const float* part = (const float*)(args.ws + WS_PART); const f32x4* g = (const f32x4*)argp(args, I_GFINAL); float* out = args.out; const bf16* xb = (const bf16*)(args.ws + WS_XB);
    f32x4 gg[4];
#pragma unroll
    for (int j = 0; j < 4; ++j) gg[j] = g[lane + 64 * j];
    for (int m = gw; m < M; m += 4 * ngw) { uint2 v[4][4]; f32x4 pp[4][4];
#pragma unroll
        for (int r = 0; r < 4; ++r) { const int mm = (m + r * ngw < M) ? m + r * ngw : m; const uint2* xr = (const uint2*)(xb + (size_t)mm * D); const f32x4* pr = (const f32x4*)(part + (size_t)mm * 16);
#pragma unroll
            for (int j = 0; j < 4; ++j) { v[r][j] = xr[lane + 64 * j]; pp[r][j] = pr[j]; } }
#pragma unroll
        for (int r = 0; r < 4; ++r) { const int mm = m + r * ngw; if (mm < M) { f32x4* orow = (f32x4*)(out + (size_t)mm * D);
            const f32x4 a = pp[r][0], b = pp[r][1], c = pp[r][2], d = pp[r][3];
            const float rr = rsqrtf((((a.x + a.y) + (a.z + a.w)) + ((b.x + b.y) + (b.z + b.w)) + ((c.x + c.y) + (c.z + c.w)) + ((d.x + d.y) + (d.z + d.w))) * (1.f / D) + EPS);
#pragma unroll
            for (int j = 0; j < 4; ++j) { const f32x4 x = {blo(v[r][j].x), bhi(v[r][j].x), blo(v[r][j].y), bhi(v[r][j].y)}; orow[lane + 64 * j] = x * rr * gg[j]; } } } }
}
#ifndef PROBE
#define PROBE 0
#endif
#define IN(k) (lo <= (k) && (k) < hi)
#if defined(WAITPROBE) && WAITPROBE
#define SEAM(k) do { if (hi > (k) + 1) { const unsigned long long w0_ = __builtin_amdgcn_s_memrealtime(); xcd_barrier(bar); if ((WAITSEL >> (((k) >= PH_L0) ? (((k) - PH_L0) % PH_PER_LAYER) : 13 + (k))) & 1) *wacc += __builtin_amdgcn_s_memrealtime() - w0_; } } while (0)
#else
#define SEAM(k) do { if (hi > (k) + 1) { xcd_barrier(bar); if (PROBE & 512) xcd_barrier(bar); } } while (0)
#endif
#define SEAMG(k) do { if (hi > (k) + 1) grp_barrier(bar); } while (0)
#define SEAML(k) do { if (hi > (k) + 1) loc_barrier(bar); } while (0)
#define WSP(T, off) ((T*)(ws + (off)))
#define PHASE_IDS() int tid = wave * 64 + lane_id(); asm volatile("" : "+v"(tid)); int lane = tid & 63
constexpr int RSTD_OFF = RING_BYTES, RSTD_SLOTS = (MISC_OFF - RING_BYTES) / 1024;
DI bool slot_pm(const pg8::StaticOrder& S, int slot, int& pm) {
    if (S.G == 256 && S.nM == 128) { const int j = S.c >> 3, t = 32 * slot + j; pm = 16 * (S.c & 7) + (j & 7) + ((t >= 8 * S.nN) ? 8 : 0); return t < 16 * S.nN; }
    pg8::Unit u; const bool ok = S.next(slot, u); pm = u.pm; return ok;
}
DI pg8::RstdTab rstd_table(const pg8::StaticOrder& S, const float* part, LAS unsigned char* lds, int tid) {
    pg8::RstdTab rt; rt.tab = (const LAS float*)(lds + RSTD_OFF);
    LAS float* tab = (LAS float*)(lds + RSTD_OFF);
    constexpr int NE = RSTD_SLOTS * 256 / NTHR;
#pragma unroll
    for (int b0 = 0; b0 < NE; b0 += 6) { f32x4 pv[6][4]; bool ok[6];
        { pg8::Unit u0; if (b0 > 0 && !S.next(b0 * 2, u0)) break; }
#pragma unroll
        for (int k = 0; k < 6; ++k) { const int e = tid + NTHR * (b0 + k); int pm; ok[k] = slot_pm(S, e >> 8, pm); const f32x4* p = (const f32x4*)(part + ((size_t)(ok[k] ? pm : 0) * 256 + (e & 255)) * 16);
#pragma unroll
            for (int q = 0; q < 4; ++q) pv[k][q] = p[q]; }
#pragma unroll
        for (int k = 0; k < 6; ++k) { const int e = tid + NTHR * (b0 + k); const f32x4 a = pv[k][0], b = pv[k][1], c = pv[k][2], d = pv[k][3];
            const float s = ((a.x + a.y) + (a.z + a.w)) + ((b.x + b.y) + (b.z + b.w)) + ((c.x + c.y) + (c.z + c.w)) + ((d.x + d.y) + (d.z + d.w));
            if (ok[k]) tab[e] = rsqrtf(s * (1.f / D) + EPS); } }
    __syncthreads();
    return rt;
}
#define GEMM_SITE_RT(EpiT, gexpr, ...) do { pg8::Gemm g = gexpr; pg8::StaticOrder S; S.init(g.M, g.N, G, (int)blockIdx.x); int tid_rt = wave * 64 + lane_id(); asm volatile("" : "+v"(tid_rt)); \
        const pg8::RstdTab rt = rstd_table(S, WSP(float, WS_PART), lds, tid_rt); pg8::EpiT E = pg8::EpiT{rt, __VA_ARGS__}; pg8::gemm_phase<pg8::EpiT, pg8::StaticOrder, true, true>(lds, g, S, E, wave); } while (0)
#define GEMM_SITE(EpiT, gexpr, eexpr) do { pg8::Gemm g = gexpr; pg8::StaticOrder S; S.init(g.M, g.N, G, (int)blockIdx.x); pg8::EpiT E = eexpr; pg8::gemm_phase<pg8::EpiT, pg8::StaticOrder, true, true>(lds, g, S, E, wave); } while (0)

template <int L>
DI void layer_phases(const Args& args, LAS unsigned char* lds, const XcdBarrier& bar, const int lo, const int hi, const int G, const int wave, unsigned long long* wacc) {
    unsigned char* const ws = args.ws;
    constexpr int l = L, base = PH_L0 + L * PH_PER_LAYER;
    const int gw = blockIdx.x * NWAVES + wave, ngw = G * NWAVES;
    unsigned char* const wlb = wl_base(args, l);
    if (IN(base + LP_GUA)) {
#if defined(CLKPROBE) && CLKPROBE == 2
        const unsigned long long gc0_ = __builtin_amdgcn_s_memtime(), gr0_ = __builtin_amdgcn_s_memrealtime();
#endif
        GEMM_SITE_RT(EpiSwiglu, (pg8::Gemm{WSP(bf16, WS_XB), (bf16*)(wlb + WL_GUA), M, 2 * DFF, D}), WSP(bf16, WS_H));
#if defined(CLKPROBE) && CLKPROBE == 2
        wacc[1] += __builtin_amdgcn_s_memtime() - gc0_; wacc[2] += __builtin_amdgcn_s_memrealtime() - gr0_;
#endif
        if (PROBE & 1) { xcd_barrier(bar);
        GEMM_SITE_RT(EpiSwiglu, (pg8::Gemm{WSP(bf16, WS_XB), (bf16*)(wlb + WL_GUA), M, 2 * DFF, D}), WSP(bf16, WS_H));
        }
        SEAMG(base + LP_GUA); }
    if (IN(base + LP_DNA)) {
        GEMM_SITE(EpiRes, (pg8::Gemm{WSP(bf16, WS_H), (bf16*)(wlb + WL_DNA), M, D, DFF}), (pg8::EpiRes{WSP(bf16, WS_XB), WSP(float, WS_PART), 0.5f}));
        if (PROBE & 32) { xcd_barrier(bar);
        GEMM_SITE(EpiRes, (pg8::Gemm{WSP(bf16, WS_H), (bf16*)(wlb + WL_DNA), M, D, DFF}), (pg8::EpiRes{WSP(bf16, WS_XB), WSP(float, WS_PART), 0.0f}));
        }
        SEAM(base + LP_DNA);      }
    if (IN(base + LP_WIN)) {
        GEMM_SITE_RT(EpiScale, (pg8::Gemm{WSP(bf16, WS_XB), (bf16*)(wlb + WL_IN), M, DINP, D}), WSP(bf16, WS_P), 0, 1.f);
        if (PROBE & 1) { xcd_barrier(bar);
        GEMM_SITE_RT(EpiScale, (pg8::Gemm{WSP(bf16, WS_XB), (bf16*)(wlb + WL_IN), M, DINP, D}), WSP(bf16, WS_P), 0, 1.f);
        }
        SEAM(base + LP_WIN); }
    if (IN(base + LP_MIXA) || IN(base + LP_SCAN) || IN(base + LP_MIXB)) {
        MixCtx cx; cx.ws = ws; cx.w_a2 = (const float*)argp(args, I_GLAWA2) + (size_t)l * 16 * 192; cx.b_a = (const float*)argp(args, I_GLABA) + l * 192; cx.gla_gn = (const float*)argp(args, I_GLAGN) + l * 384;
        cx.ret_gn = (const float*)argp(args, I_RETGN) + l * 384; cx.conv = (const float*)argp(args, I_MLCONV) + (size_t)l * 4 * 512; cx.b_i = (const float*)argp(args, I_MLBI) + l * 4; cx.b_f = (const float*)argp(args, I_MLBF) + l * 4;
        if (IN(base + LP_MIXA)) { PHASE_IDS(); mix_passA(cx, lds + wave * WSLICE, wave, G, lane); SEAM(base + LP_MIXA); }
        if (IN(base + LP_SCAN)) { PHASE_IDS(); mix_scan(cx, blockIdx.x * NTHR + tid, G * NTHR); if (l + 1 < DEPTH) convert_layer(args, l + 1, (LAS float*)(lds + wave * WSLICE), gw, ngw, lane); SEAM(base + LP_SCAN); }
        if (PROBE & 2) { { PHASE_IDS(); mix_passA(cx, lds + wave * WSLICE, wave, G, lane); } xcd_barrier(bar); { PHASE_IDS(); mix_scan(cx, blockIdx.x * NTHR + tid, G * NTHR); } xcd_barrier(bar); { PHASE_IDS(); mix_passB(cx, lds + wave * WSLICE, wave, G, lane); } xcd_barrier(bar); }
        if (IN(base + LP_MIXB)) { { PHASE_IDS(); mix_passB(cx, lds + wave * WSLICE, wave, G, lane); } if (PROBE & 16) { xcd_barrier(bar); PHASE_IDS(); mix_passB(cx, lds + wave * WSLICE, wave, G, lane); } SEAM(base + LP_MIXB); }
    }
    if (IN(base + LP_WOUT)) {
        GEMM_SITE(EpiRes, (pg8::Gemm{WSP(bf16, WS_Y), (bf16*)(wlb + WL_OUT), M, D, D}), (pg8::EpiRes{WSP(bf16, WS_XB), WSP(float, WS_PART), 1.0f}));
        if (PROBE & 32) { xcd_barrier(bar);
        GEMM_SITE(EpiRes, (pg8::Gemm{WSP(bf16, WS_Y), (bf16*)(wlb + WL_OUT), M, D, D}), (pg8::EpiRes{WSP(bf16, WS_XB), WSP(float, WS_PART), 0.0f}));
        }
        SEAMG(base + LP_WOUT); }
    if (IN(base + LP_XQ)) {
        GEMM_SITE_RT(EpiScale, (pg8::Gemm{WSP(bf16, WS_XB), (bf16*)(wlb + WL_XQ), M, D, D}), WSP(bf16, WS_Q), D, 0.0625f * 1.4426950408889634f);
        if (PROBE & 1) { xcd_barrier(bar);
        GEMM_SITE_RT(EpiScale, (pg8::Gemm{WSP(bf16, WS_XB), (bf16*)(wlb + WL_XQ), M, D, D}), WSP(bf16, WS_Q), D, 0.0625f * 1.4426950408889634f);
        }
        SEAML(base + LP_XQ);     }
    if (IN(base + LP_ATT)) { PHASE_IDS(); (void)lane; attn_phase(ws, l, lds, G, tid, wave); if (PROBE & 4) { xcd_barrier(bar); attn_phase(ws, l, lds, G, tid, wave); } SEAMG(base + LP_ATT); }
    if (IN(base + LP_XO)) {
        GEMM_SITE(EpiRes, (pg8::Gemm{WSP(bf16, WS_O), (bf16*)(wlb + WL_XO), M, D, D}), (pg8::EpiRes{WSP(bf16, WS_XB), WSP(float, WS_PART), 1.0f}));
        if (PROBE & 32) { xcd_barrier(bar);
        GEMM_SITE(EpiRes, (pg8::Gemm{WSP(bf16, WS_O), (bf16*)(wlb + WL_XO), M, D, D}), (pg8::EpiRes{WSP(bf16, WS_XB), WSP(float, WS_PART), 0.0f}));
        }
        SEAMG(base + LP_XO); }
    if (IN(base + LP_GUB)) {
        GEMM_SITE_RT(EpiSwiglu, (pg8::Gemm{WSP(bf16, WS_XB), (bf16*)(wlb + WL_GUB), M, 2 * DFF, D}), WSP(bf16, WS_H));
        if (PROBE & 1) { xcd_barrier(bar);
        GEMM_SITE_RT(EpiSwiglu, (pg8::Gemm{WSP(bf16, WS_XB), (bf16*)(wlb + WL_GUB), M, 2 * DFF, D}), WSP(bf16, WS_H));
        }
        SEAMG(base + LP_GUB); }
    if (IN(base + LP_DNB)) {
        GEMM_SITE(EpiRes, (pg8::Gemm{WSP(bf16, WS_H), (bf16*)(wlb + WL_DNB), M, D, DFF}), (pg8::EpiRes{WSP(bf16, WS_XB), WSP(float, WS_PART), 0.5f}));
        if (PROBE & 32) { xcd_barrier(bar);
        GEMM_SITE(EpiRes, (pg8::Gemm{WSP(bf16, WS_H), (bf16*)(wlb + WL_DNB), M, D, DFF}), (pg8::EpiRes{WSP(bf16, WS_XB), WSP(float, WS_PART), 0.0f}));
        }
        if (L + 1 < DEPTH) SEAMG(base + LP_DNB); else SEAM(base + LP_DNB); }
}

__global__ void __launch_bounds__(NTHR, 2) fwd(Args args) {
    extern __shared__ __attribute__((aligned(16))) unsigned char lds_raw[];
    LAS unsigned char* lds = (LAS unsigned char*)lds_raw;
    const int wave = __builtin_amdgcn_readfirstlane((int)threadIdx.x >> 6);
    const int G = gridDim.x;
    unsigned char* const ws = args.ws;
    for (int u = wave * 64 + lane_id(); u < (LDS_BYTES - MISC_OFF) / 4; u += NTHR) ((LAS unsigned*)(lds + MISC_OFF))[u] = 0u;
    __syncthreads();
    const XcdBarrier bar = xcd_barrier_post((unsigned*)(ws + WS_CTL) + CW_BAR + args.li * XCD_BAR_WORDS, (volatile LAS unsigned*)(lds + MISC_OFF), wave);
    grp_post(bar);
    const int lo = args.ph_lo, hi = args.ph_hi;
    unsigned long long wacc_a[3] = {0ull, 0ull, 0ull}; unsigned long long* wacc = wacc_a; unsigned long long& wacc_v = wacc_a[0];
#if defined(CLKPROBE) && CLKPROBE
    const unsigned long long clk_c0 = __builtin_amdgcn_s_memtime(), clk_r0 = __builtin_amdgcn_s_memrealtime();
#endif

    if (IN(PH_PRO)) { PHASE_IDS();
        const int gw = blockIdx.x * NWAVES + wave, ngw = G * NWAVES; LAS float* scr = (LAS float*)(lds + wave * WSLICE);
        convert_kv(args, scr, gw, ngw, lane);
        convert_layer(args, 0, scr, gw, ngw, lane);
        stats_rows<4>((const float*)argp(args, I_X), WSP(bf16, WS_XB), WSP(float, WS_PART), gw, ngw, M, lane);
        stats_rows<1>((const float*)argp(args, I_MEM), WSP(bf16, WS_MEMB), WSP(float, WS_MEMP), gw, ngw, BATCH * MEMLEN, lane);
        { const int* pos = (const int*)argp(args, I_POS); float2* rope = WSP(float2, WS_ROPE);
          for (int i = blockIdx.x * NTHR + tid; i < M * 16; i += G * NTHR) { const int r = i >> 4, m = i & 15;
            const float invf = 1.0f / powf(10000.0f, (float)m / 15.0f); const float ang = (float)pos[r] * invf;
            double tr = (double)ang * 0.15915494309189535; tr -= __builtin_rint(tr);
            rope[i] = make_float2(__builtin_amdgcn_cosf((float)tr), __builtin_amdgcn_sinf((float)tr)); } }
        SEAM(PH_PRO); grp_decide(bar, G);
    }
    if (IN(PH_KV)) {
        GEMM_SITE(EpiKV, (pg8::Gemm{WSP(bf16, WS_MEMB), WSP(bf16, WS_WKV), BATCH * MEMLEN, DEPTH * 2048, D}), (pg8::EpiKV{WSP(float, WS_MEMP), WSP(bf16, WS_KB), WSP(bf16, WS_VT)}));
        SEAM(PH_KV);
    }
    layer_phases<0>(args, lds, bar, lo, hi, G, wave, wacc);
    layer_phases<1>(args, lds, bar, lo, hi, G, wave, wacc);
    layer_phases<2>(args, lds, bar, lo, hi, G, wave, wacc);
    layer_phases<3>(args, lds, bar, lo, hi, G, wave, wacc);
    if (IN(PH_FINAL)) { PHASE_IDS(); final_phase(args, blockIdx.x * NWAVES + wave, G * NWAVES, lane); }
#if defined(WAITPROBE) && WAITPROBE
#if WAITPROBE == 2000
    { unsigned* tb_ = (unsigned*)(ws + WS_CTL) + 4096;
      if (wave == 0 && lane_id() == 0) __hip_atomic_store(tb_ + blockIdx.x, 1u + xb_xcc_id(), __ATOMIC_RELAXED, __HIP_MEMORY_SCOPE_AGENT);
      xcd_barrier(bar);
      if (blockIdx.x == 0 && wave == 0) { unsigned mis = 0; for (int b_ = 0; b_ < G; ++b_) mis += __hip_atomic_load(tb_ + b_, __ATOMIC_RELAXED, __HIP_MEMORY_SCOPE_AGENT) != __hip_atomic_load(tb_ + (b_ & 7), __ATOMIC_RELAXED, __HIP_MEMORY_SCOPE_AGENT);
          const unsigned long long r1 = __builtin_amdgcn_s_memrealtime(); while (__builtin_amdgcn_s_memrealtime() - r1 < 10000ull + (unsigned long long)mis * 1000ull) __builtin_amdgcn_s_sleep(8); } }
#else
    if (blockIdx.x == WAITPROBE - 1 && wave == 0) { const unsigned long long r1 = __builtin_amdgcn_s_memrealtime(); while (__builtin_amdgcn_s_memrealtime() - r1 < wacc_v) __builtin_amdgcn_s_sleep(8); }
#endif
#endif
#if defined(CLKPROBE) && CLKPROBE
    if (blockIdx.x == 0 && wave == 0) { const unsigned long long r1 = __builtin_amdgcn_s_memrealtime(); const unsigned long long dc = (CLKPROBE == 2) ? wacc_a[1] : __builtin_amdgcn_s_memtime() - clk_c0, dr = (CLKPROBE == 2) ? wacc_a[2] : r1 - clk_r0;
        const unsigned long long mhz = dc * 100ull / (dr ? dr : 1ull); while (__builtin_amdgcn_s_memrealtime() - r1 < mhz * 50ull) __builtin_amdgcn_s_sleep(8); }
#endif
}
#undef IN
#undef SEAM
extern "C" void kernel_launch(void* const* d_in, const int* in_sizes, int n_in, void* d_out, int out_size, void* d_ws, size_t ws_size, hipStream_t stream) {
    static int grid = 0;
    if (grid == 0) {
        if (n_in != 25 || ws_size < WS_END || out_size != M * D) { fprintf(stderr, "kernel_launch: unexpected inputs (n_in %d, ws %zu, out %d)\n", n_in, ws_size, out_size); grid = -1; return; }
        int dev = 0, cus = 0, per_cu = 0;
        if (hipGetDevice(&dev) != hipSuccess || hipDeviceGetAttribute(&cus, hipDeviceAttributeMultiprocessorCount, dev) != hipSuccess) { grid = -1; return; }
        if (hipFuncSetAttribute((const void*)fwd, hipFuncAttributeMaxDynamicSharedMemorySize, LDS_BYTES) != hipSuccess) { fprintf(stderr, "kernel_launch: hipFuncSetAttribute failed\n"); grid = -1; return; }
        if (hipOccupancyMaxActiveBlocksPerMultiprocessor(&per_cu, (const void*)fwd, NTHR, LDS_BYTES) != hipSuccess || per_cu < 1) fprintf(stderr, "kernel_launch: occupancy query says %d\n", per_cu);
        (void)hipGetLastError();
        if (cus < 128) { fprintf(stderr, "kernel_launch: needs >= 128 CUs (rstd table slots)\n"); grid = -1; return; }
        grid = cus & ~7;
    }
    if (grid < 0) return;
    (void)hipMemsetAsync((char*)d_ws + WS_CTL, 0, CTL_ZERO_BYTES, stream);
    unsigned char* ws = (unsigned char*)d_ws; float* out = (float*)d_out;
    int li = 0;
    auto launch = [&](int lo, int hi) {
        Args a{}; for (int i = 0; i < 25; ++i) a.in[i] = d_in[i];
        a.out = out; a.ws = ws; a.ph_lo = lo; a.ph_hi = hi; a.li = li++; a.pad = 0;
        hipLaunchKernelGGL(fwd, dim3(grid), dim3(NTHR), LDS_BYTES, stream, a);
    };
    launch(PH_PRO, PH_END);
}
```

```cpp
#define EPIPROBE 0
#define CLKPROBE 0
#define WAITPROBE 0
#define WAITSEL 0x7fff
#define REPPROBE 0
#include <hip/hip_runtime.h>
#include <cstdio>
#include <cstdint>

typedef unsigned short bf16;
typedef short bf16x8 __attribute__((ext_vector_type(8)));
typedef float f32x4 __attribute__((ext_vector_type(4)));
typedef float f32x16 __attribute__((ext_vector_type(16)));
typedef unsigned u32x4 __attribute__((ext_vector_type(4)));
#define DI __device__ __forceinline__
#define LAS __attribute__((address_space(3)))

constexpr int BATCH = 4, SEQ = 8192, D = 1024, DEPTH = 4, MEMLEN = 256;
constexpr int M = BATCH * SEQ;
constexpr int DFF = 2816, DIN = 3352, DINP = 3584;
constexpr float EPS = 1e-6f;
constexpr int C_GQ = 0, C_GK = 192, C_GV = 384, C_GA = 768, C_GR = 784, C_RQ = 1168, C_RK = 1360, C_RV = 1552, C_RG = 1936,
              C_MQ = 2320, C_MK = 2576, C_MV = 2832, C_MO = 3088, C_MI = 3344, C_MF = 3348;

constexpr size_t MiB = 1u << 20;
constexpr size_t WS_CTL = 0, WS_ROPE = 1 * MiB, WS_PART = 5 * MiB, WS_MEMB = 7 * MiB, WS_MEMP = 9 * MiB, WS_KB = 10 * MiB, WS_VT = 18 * MiB,
                 WS_WKV = 26 * MiB, WS_WL = 42 * MiB, WS_XB = 88 * MiB, WS_R = 152 * MiB,
                 WS_P = WS_R, WS_ST = 376 * MiB, WS_H = WS_R, WS_Q = 328 * MiB, WS_O = 392 * MiB, WS_Y = 456 * MiB, WS_END = 520 * MiB;
constexpr size_t WL_GUA = 0, WL_DNA = WL_GUA + (size_t)2 * DFF * D * 2, WL_IN = WL_DNA + (size_t)D * DFF * 2, WL_OUT = WL_IN + (size_t)DINP * D * 2,
                 WL_XQ = WL_OUT + (size_t)D * D * 2, WL_XO = WL_XQ + (size_t)D * D * 2, WL_GUB = WL_XO + (size_t)D * D * 2, WL_DNB = WL_GUB + (size_t)2 * DFF * D * 2,
                 WL_END = WL_DNB + (size_t)D * DFF * 2;
static_assert(WS_WL + WL_END <= WS_XB, "per-layer weights fit");
static_assert(WS_P + (size_t)M * DINP * 2 <= WS_ST && WS_H + (size_t)M * DFF * 2 <= WS_Q && WS_Q + (size_t)M * D * 2 <= WS_O && WS_O + (size_t)M * D * 2 <= WS_Y && WS_Y + (size_t)M * D * 2 <= WS_END && WS_ST + 44 * MiB <= WS_Y, "ws map");
constexpr int CW_BAR = 0;
constexpr size_t CTL_ZERO_BYTES = 36864;

DI float bf2f(bf16 b) { return __uint_as_float(((unsigned)b) << 16); }
typedef float f32x2_t_ __attribute__((ext_vector_type(2)));
typedef __bf16 bf16x2_t_ __attribute__((ext_vector_type(2)));
DI unsigned pk2(float lo, float hi) { const f32x2_t_ v = {lo, hi}; const bf16x2_t_ b = __builtin_convertvector(v, bf16x2_t_); return __builtin_bit_cast(unsigned, b); }
DI bf16 f2bf(float f) { return (bf16)(pk2(f, f) & 0xffffu); }
DI float sigmoidf_(float x) { return __builtin_amdgcn_rcpf(1.f + __expf(-x)); }
DI float siluf_(float x) { return x * __builtin_amdgcn_rcpf(1.f + __expf(-x)); }
DI float logsigf_(float x) { return fminf(x, 0.f) - __logf(1.f + __expf(-fabsf(x))); }
DI float wave_sum(float v) {
#pragma unroll
    for (int o = 1; o < 64; o <<= 1) v += __shfl_xor(v, o);
    return v;
}
DI float wave_max(float v) {
#pragma unroll
    for (int o = 1; o < 64; o <<= 1) v = fmaxf(v, __shfl_xor(v, o));
    return v;
}
DI float row_rstd(const float* part, int row) {
    const f32x4* p = (const f32x4*)(part + (size_t)row * 16);
    const f32x4 a = p[0], b = p[1], c = p[2], d = p[3];
    const float s = ((a.x + a.y) + (a.z + a.w)) + ((b.x + b.y) + (b.z + b.w)) + ((c.x + c.y) + (c.z + c.w)) + ((d.x + d.y) + (d.z + d.w));
    return rsqrtf(s * (1.f / D) + EPS);
}
DI int lane_id() { int l; asm volatile("v_mbcnt_lo_u32_b32 %0, -1, 0\n\tv_mbcnt_hi_u32_b32 %0, -1, %0" : "=v"(l)); return l; }
namespace pg8 {
#define PG8_LAS __attribute__((address_space(3)))
typedef unsigned short bf16_t;
typedef short bf16x8 __attribute__((ext_vector_type(8)));
typedef float f32x4 __attribute__((ext_vector_type(4)));
typedef unsigned u32x4 __attribute__((ext_vector_type(4)));
constexpr int BM = 256, BK = 64, HALF = 128, HTB = HALF * BK * 2  , STAGE_BYTES = 8 * HTB, NXCD = 8, WGM = 8;

__host__ __device__ __forceinline__ int lds_byte(int r, int c) { const int st = (r >> 4) * 2 + (c >> 5), rr = r & 15, cc = c & 31, ob = rr * 64 + cc * 2; return st * 1024 + (ob ^ (((ob >> 9) & 1) << 5)); }
__host__ __device__ __forceinline__ void stage_rc(int b, int& R, int& C) { const int st = b / 1024, sb = b % 1024, swz = sb ^ (((sb >> 9) & 1) << 5); R = (st >> 1) * 16 + swz / 64; C = (st & 1) * 32 + (swz % 64) / 2; }
__host__ __device__ __forceinline__ int perm32(int rho) { const int n = rho >> 4, i = rho & 15; return 8 * (i >> 2) + 4 * n + (i & 3); }

struct Unit { int pm, pn, idx; };
struct Gemm { const bf16_t* A; const bf16_t* Bt; int M, N, K; };

struct StaticOrder {
    int nM, nN, nwg, G, c;
    __host__ __device__ void init(int M, int N, int G_, int c_) { nM = M / BM; nN = N / BM; nwg = nM * nN; G = G_; c = c_; }
    __host__ __device__ bool next(int i, Unit& u) const {
        const long L = (long)i * G + c; if (L >= nwg) return false;
        int wgid = (int)L; { const int q = nwg / NXCD, r = nwg % NXCD, xcd = wgid % NXCD, off = wgid / NXCD; wgid = (xcd < r ? xcd * (q + 1) : r * (q + 1) + (xcd - r) * q) + off; }
        const int nig = WGM * nN, gid = wgid / nig, fm = gid * WGM, gsz = (nM - fm) < WGM ? (nM - fm) : WGM;
        u.pm = fm + ((wgid % nig) % gsz); u.pn = (wgid % nig) / gsz; u.idx = i; return true;
    }
    __device__ __forceinline__ void a_ready(const Unit&) const {}
    __device__ __forceinline__ void done(const Unit&) const {}
};

__device__ __forceinline__ unsigned cvt_pk_bf16(float lo, float hi) { unsigned r; asm volatile("v_cvt_pk_bf16_f32 %0, %1, %2" : "=v"(r) : "v"(lo), "v"(hi)); return r; }
__device__ __forceinline__ u32x4 pack8(const f32x4 v0, const f32x4 v1) { u32x4 w; w.x = cvt_pk_bf16(v0[0], v0[1]); w.y = cvt_pk_bf16(v0[2], v0[3]); w.z = cvt_pk_bf16(v1[0], v1[1]); w.w = cvt_pk_bf16(v1[2], v1[3]); return w; }
__device__ __forceinline__ f32x4 silu4(const f32x4 a) { f32x4 r; r[0] = siluf_(a[0]); r[1] = siluf_(a[1]); r[2] = siluf_(a[2]); r[3] = siluf_(a[3]); return r; }

struct RstdTab { const PG8_LAS float* tab;
    __device__ __forceinline__ float get(const Unit& u, int r) const { return tab[u.idx * 256 + r]; } };
struct EpiSwiglu {
    static constexpr bool PERM = true, AFTER_DRAIN = false, IDEMP = true;
    RstdTab rt; bf16_t* H;
    __device__ __forceinline__ static f32x4 swiglu4(const f32x4 a, const f32x4 g, float c1, float rs2) {
        const f32x4 t = a * c1; f32x4 e; e[0] = __builtin_amdgcn_exp2f(t[0]); e[1] = __builtin_amdgcn_exp2f(t[1]); e[2] = __builtin_amdgcn_exp2f(t[2]); e[3] = __builtin_amdgcn_exp2f(t[3]);
        const f32x4 d = e + 1.0f; f32x4 r; r[0] = __builtin_amdgcn_rcpf(d[0]); r[1] = __builtin_amdgcn_rcpf(d[1]); r[2] = __builtin_amdgcn_rcpf(d[2]); r[3] = __builtin_amdgcn_rcpf(d[3]);
        return ((a * g) * rs2) * r; }
    __device__ __forceinline__ void operator()(const f32x4 (&acc)[2][2][4][2], const Unit& u, int wr, int wc, int fr, int fq) const {
        const int r0 = wr * 64 + fr, col0 = u.pn * 128 + wc * 32 + 8 * fq;
#pragma unroll
        for (int ai = 0; ai < 2; ++ai)
#pragma unroll
            for (int m = 0; m < 4; ++m) { const int r = r0 + ai * HALF + m * 16; const float rs = rt.get(u, r), c1 = rs * -1.4426950408889634f, rs2 = rs * rs;
                *(u32x4*)(H + (size_t)(u.pm * BM + r) * DFF + col0) = pack8(swiglu4(acc[ai][0][m][0], acc[ai][1][m][0], c1, rs2), swiglu4(acc[ai][0][m][1], acc[ai][1][m][1], c1, rs2)); }
    }
};
struct EpiRes {
    static constexpr bool PERM = true, AFTER_DRAIN = false, IDEMP = false;
    bf16_t* xb; float* part; float alpha;
    __device__ __forceinline__ void operator()(const f32x4 (&acc)[2][2][4][2], const Unit& u, int wr, int wc, int fr, int fq) const {
        const int row0 = u.pm * BM + wr * 64 + fr, col0 = u.pn * BM + wc * 32 + 8 * fq;
        u32x4 xv[2][4][2];
#pragma unroll
        for (int ai = 0; ai < 2; ++ai)
#pragma unroll
            for (int m = 0; m < 4; ++m)
#pragma unroll
                for (int bj = 0; bj < 2; ++bj) xv[ai][m][bj] = *(const u32x4*)(xb + (size_t)(row0 + ai * HALF + m * 16) * D + col0 + bj * HALF);
#pragma unroll
        for (int ai = 0; ai < 2; ++ai)
#pragma unroll
            for (int m = 0; m < 4; ++m) { const int row = row0 + ai * HALF + m * 16; bf16_t* xp = xb + (size_t)row * D + col0; float ss = 0.f;
#pragma unroll
                for (int bj = 0; bj < 2; ++bj) { const u32x4 v = xv[ai][m][bj];
                    const f32x4 x0 = {__uint_as_float(v.x << 16), __uint_as_float(v.x & 0xffff0000u), __uint_as_float(v.y << 16), __uint_as_float(v.y & 0xffff0000u)};
                    const f32x4 x1 = {__uint_as_float(v.z << 16), __uint_as_float(v.z & 0xffff0000u), __uint_as_float(v.w << 16), __uint_as_float(v.w & 0xffff0000u)};
                    const f32x4 y0 = x0 + acc[ai][bj][m][0] * alpha, y1 = x1 + acc[ai][bj][m][1] * alpha;
                    *(u32x4*)(xp + bj * HALF) = pack8(y0, y1);
                    ss += ((y0[0] * y0[0] + y0[1] * y0[1]) + (y0[2] * y0[2] + y0[3] * y0[3])) + ((y1[0] * y1[0] + y1[1] * y1[1]) + (y1[2] * y1[2] + y1[3] * y1[3])); }
                ss += __shfl_xor(ss, 16); ss += __shfl_xor(ss, 32);
                if (fq == 0) part[(size_t)row * 16 + u.pn * 4 + wc] = ss; }
    }
};
struct EpiScale {
    static constexpr bool PERM = true, AFTER_DRAIN = false, IDEMP = true;
    RstdTab rt; bf16_t* O; int ldc; float scale;
    __device__ __forceinline__ void operator()(const f32x4 (&acc)[2][2][4][2], const Unit& u, int wr, int wc, int fr, int fq) const {
        const int r0 = wr * 64 + fr, col0 = u.pn * BM + wc * 32 + 8 * fq;
#pragma unroll
        for (int ai = 0; ai < 2; ++ai)
#pragma unroll
            for (int m = 0; m < 4; ++m) { const int r = r0 + ai * HALF + m * 16; const float rs = rt.get(u, r) * scale; const int row = u.pm * BM + r;
                bf16_t* rowp = ldc ? O + (size_t)row * ldc + col0 : O + (((size_t)(row >> 6) * (DINP / 16) + (col0 >> 4)) * 64 + (row & 63)) * 16 + (col0 & 15);
#pragma unroll
                for (int bj = 0; bj < 2; ++bj) *(u32x4*)(rowp + (ldc ? bj * HALF : bj * (HALF / 16) * 1024)) = pack8(acc[ai][bj][m][0] * rs, acc[ai][bj][m][1] * rs); }
    }
};
struct EpiKV {
    static constexpr bool PERM = true, AFTER_DRAIN = false, IDEMP = false;
    const float* mp; bf16_t* KB; bf16_t* VT;
    __device__ __forceinline__ void operator()(const f32x4 (&acc)[2][2][4][2], const Unit& u, int wr, int wc, int fr, int fq) const {
        const int l = u.pn >> 3, pc = u.pn & 7; const int row0 = u.pm * BM + wr * 64 + fr;
#pragma unroll
        for (int ai = 0; ai < 2; ++ai)
#pragma unroll
            for (int m = 0; m < 4; ++m) { const int row = row0 + ai * HALF + m * 16; const float rs = rsqrtf(mp[(size_t)row * 16] * (1.f / D) + EPS);
#pragma unroll
                for (int bj = 0; bj < 2; ++bj) { const f32x4 v0 = acc[ai][bj][m][0] * rs, v1 = acc[ai][bj][m][1] * rs;
                    if (pc < 4) { *(u32x4*)(KB + ((size_t)l * 1024 + row) * 1024 + pc * 256 + bj * HALF + wc * 32 + 8 * fq) = pack8(v0, v1); }
                    else { const int vc = (pc - 4) * 256 + bj * HALF + wc * 32 + 8 * fq; const int key = row & 255, kp = (key & ~12) | ((key & 4) << 1) | ((key & 8) >> 1);
                        bf16_t* vp = VT + (((size_t)l * 4 + u.pm) * 1024 + vc) * 256 + kp;
#pragma unroll
                        for (int e = 0; e < 4; ++e) { vp[(size_t)e * 256] = f2bf(v0[e]); vp[(size_t)(e + 4) * 256] = f2bf(v1[e]); } } } }
    }
};
template <class Epi, class Sched, bool ALIGN_EPI = false, bool SP2 = false>
__device__ __forceinline__ void gemm_phase(PG8_LAS unsigned char* lds, const Gemm g, const Sched& S, const Epi& E, const int wave_) {
    int tid_ = wave_ * 64 + lane_id(); asm volatile("" : "+v"(tid_));
    const int tid = tid_, wid = wave_, lane = tid & 63, wr = wid >> 2, wc = wid & 3, fr = lane & 15, fq = lane >> 4;
    const int K = g.K, nt = K / BK;
    unsigned voffA[2], voffB[2];
#pragma unroll
    for (int i = 0; i < 2; ++i) { int R, C; stage_rc(tid * 16 + i * 8192, R, C); const int Rb = Epi::PERM ? ((R & ~31) + perm32(R & 31)) : R;
        voffA[i] = (unsigned)(R * K + C) * 2u; voffB[i] = (unsigned)(Rb * K + C) * 2u; }
    const size_t kstep = (size_t)(BK * 2);
    const size_t hstep = (size_t)HALF * K * 2;
    const size_t tstep = 2 * hstep;
    const unsigned ldsw = (unsigned)wid * 1024u;
    const int aoff = lds_byte(wr * 64 + fr, fq * 8), boff = lds_byte(wc * 32 + fr, fq * 8);
#define PG8_SA(b, h) (((b) * 2 + (h)) * HTB)
#define PG8_SB(b, h) ((4 + (b) * 2 + (h)) * HTB)
#define PG8_STAGE(bufoff, gbase, voff) do { _Pragma("unroll") for (int _i = 0; _i < 2; ++_i) \
        __builtin_amdgcn_global_load_lds((const unsigned*)((const char*)(gbase) + (voff)[_i]), (PG8_LAS unsigned*)(lds + (bufoff) + ldsw + _i * 8192), 16, 0, 0); } while (0)
#define PG8_LDA(dst, b, h) do { _Pragma("unroll") for (int m = 0; m < 4; ++m) _Pragma("unroll") for (int k = 0; k < 2; ++k) dst[m][k] = *(const PG8_LAS bf16x8*)(lds + PG8_SA(b, h) + aoff + m * 2048 + k * 1024); } while (0)
#define PG8_LDB(dst, b, h) do { _Pragma("unroll") for (int n = 0; n < 2; ++n) _Pragma("unroll") for (int k = 0; k < 2; ++k) dst[n][k] = *(const PG8_LAS bf16x8*)(lds + PG8_SB(b, h) + boff + n * 2048 + k * 1024); } while (0)
#define PG8_MMA(ai, bj, At, Bt) do { __builtin_amdgcn_s_setprio(1); _Pragma("unroll") for (int m = 0; m < 4; ++m) _Pragma("unroll") for (int n = 0; n < 2; ++n) _Pragma("unroll") for (int k = 0; k < 2; ++k) \
        acc[ai][bj][m][n] = __builtin_amdgcn_mfma_f32_16x16x32_bf16(Bt[n][k], At[m][k], acc[ai][bj][m][n], 0, 0, 0); __builtin_amdgcn_s_setprio(0); } while (0)
#define PG8_WAIT_V(n) asm volatile("s_waitcnt vmcnt(" #n ")" ::: "memory")
#define PG8_WAIT_L(n) asm volatile("s_waitcnt lgkmcnt(" #n ")" ::: "memory")
#define PG8_BAR __builtin_amdgcn_s_barrier()
#define PG8_SCHED __builtin_amdgcn_sched_barrier(0)
    Unit cur, nxt; int ui = 0;
    if (!S.next(0, cur)) return;
    f32x4 acc[2][2][4][2];
#pragma unroll
    for (int a = 0; a < 2; ++a)
#pragma unroll
        for (int b = 0; b < 2; ++b)
#pragma unroll
            for (int m = 0; m < 4; ++m)
#pragma unroll
                for (int n = 0; n < 2; ++n) acc[a][b][m][n] = (f32x4){0.f, 0.f, 0.f, 0.f};
    bf16x8 At[4][2], B0[2][2], B1[2][2];
    const char* cA = (const char*)g.A + (size_t)cur.pm * tstep; const char* cB = (const char*)g.Bt + (size_t)cur.pn * tstep;
    S.a_ready(cur);
    if constexpr (SP2) {
        PG8_STAGE(PG8_SB(0, 0), cB, voffB); PG8_STAGE(PG8_SB(0, 1), cB + hstep, voffB); PG8_STAGE(PG8_SA(0, 0), cA, voffA); PG8_STAGE(PG8_SA(0, 1), cA + hstep, voffA);
        if (wr == 1) PG8_BAR;
        PG8_WAIT_V(2); PG8_BAR;
        PG8_STAGE(PG8_SB(1, 0), cB + kstep, voffB); PG8_STAGE(PG8_SA(1, 0), cA + kstep, voffA); PG8_STAGE(PG8_SB(1, 1), cB + hstep + kstep, voffB);
        PG8_WAIT_V(6); PG8_BAR;
    } else {
        PG8_STAGE(PG8_SB(0, 0), cB, voffB); PG8_STAGE(PG8_SA(0, 0), cA, voffA); PG8_STAGE(PG8_SB(0, 1), cB + hstep, voffB); PG8_STAGE(PG8_SA(0, 1), cA + hstep, voffA);
        if (wr == 1) PG8_BAR;
        PG8_WAIT_V(4); PG8_BAR;
        PG8_STAGE(PG8_SB(1, 0), cB + kstep, voffB); PG8_STAGE(PG8_SA(1, 0), cA + kstep, voffA); PG8_STAGE(PG8_SB(1, 1), cB + hstep + kstep, voffB);
        PG8_WAIT_V(6); PG8_BAR;
    }
    for (;;) {
        const bool has_next = S.next(ui + 1, nxt);
        const char* nA = has_next ? (const char*)g.A + (size_t)nxt.pm * tstep : cA; const char* nB = has_next ? (const char*)g.Bt + (size_t)nxt.pn * tstep : cB;
        for (int t = 0; t < nt; t += 2) {
            const bool last = (t == nt - 2);
            const char* a1 = cA + (size_t)(t + 1) * kstep;
            const char* a2 = last ? nA : cA + (size_t)(t + 2) * kstep; const char* b2 = last ? nB : cB + (size_t)(t + 2) * kstep;
            const char* a3 = a2 + kstep; const char* b3 = b2 + kstep;
            if (last && has_next) S.a_ready(nxt);
            if constexpr (SP2) {
            PG8_LDB(B0, 0, 0); PG8_LDB(B1, 0, 1); PG8_SCHED; PG8_LDA(At, 0, 0); PG8_STAGE(PG8_SA(1, 1), a1 + hstep, voffA);
            PG8_WAIT_V(8); PG8_WAIT_L(0); PG8_BAR; PG8_MMA(0, 0, At, B0); PG8_MMA(0, 1, At, B1); PG8_BAR; PG8_SCHED;
            PG8_LDA(At, 0, 1); PG8_STAGE(PG8_SB(0, 0), b2, voffB); PG8_STAGE(PG8_SB(0, 1), b2 + hstep, voffB); PG8_STAGE(PG8_SA(0, 0), a2, voffA);
            PG8_WAIT_V(8); PG8_WAIT_L(0); PG8_BAR; PG8_MMA(1, 0, At, B0); PG8_MMA(1, 1, At, B1); PG8_BAR; PG8_SCHED;
            PG8_LDB(B0, 1, 0); PG8_LDB(B1, 1, 1); PG8_SCHED; PG8_LDA(At, 1, 0); PG8_STAGE(PG8_SA(0, 1), a2 + hstep, voffA);
            PG8_WAIT_V(8); PG8_WAIT_L(0); PG8_BAR; PG8_MMA(0, 0, At, B0); PG8_MMA(0, 1, At, B1); PG8_BAR; PG8_SCHED;
            PG8_LDA(At, 1, 1); PG8_STAGE(PG8_SB(1, 0), b3, voffB); PG8_STAGE(PG8_SB(1, 1), b3 + hstep, voffB); PG8_STAGE(PG8_SA(1, 0), a3, voffA);
            PG8_WAIT_V(8); PG8_WAIT_L(0); PG8_BAR; PG8_MMA(1, 0, At, B0); PG8_MMA(1, 1, At, B1); PG8_BAR; PG8_SCHED;
            } else {
            PG8_LDB(B0, 0, 0); PG8_SCHED; PG8_LDA(At, 0, 0); PG8_STAGE(PG8_SA(1, 1), a1 + hstep, voffA);
            PG8_WAIT_L(8); PG8_BAR; PG8_WAIT_L(0); PG8_MMA(0, 0, At, B0); PG8_BAR; PG8_SCHED;
            PG8_LDB(B1, 0, 1); PG8_STAGE(PG8_SB(0, 0), b2, voffB);
            PG8_BAR; PG8_WAIT_L(0); PG8_MMA(0, 1, At, B1); PG8_BAR;
            PG8_LDA(At, 0, 1); PG8_STAGE(PG8_SA(0, 0), a2, voffA);
            PG8_BAR; PG8_WAIT_L(0); PG8_MMA(1, 0, At, B0); PG8_BAR; PG8_SCHED;
            PG8_STAGE(PG8_SB(0, 1), b2 + hstep, voffB);
            PG8_WAIT_V(6); PG8_BAR; PG8_MMA(1, 1, At, B1); PG8_BAR;
            PG8_LDB(B0, 1, 0); PG8_SCHED; PG8_LDA(At, 1, 0); PG8_STAGE(PG8_SA(0, 1), a2 + hstep, voffA);
            PG8_WAIT_L(8); PG8_BAR; PG8_WAIT_L(0); PG8_MMA(0, 0, At, B0); PG8_BAR; PG8_SCHED;
            PG8_LDB(B1, 1, 1); PG8_STAGE(PG8_SB(1, 0), b3, voffB);
            PG8_BAR; PG8_WAIT_L(0); PG8_MMA(0, 1, At, B1); PG8_BAR;
            PG8_LDA(At, 1, 1); PG8_STAGE(PG8_SA(1, 0), a3, voffA);
            PG8_BAR; PG8_WAIT_L(0); PG8_MMA(1, 0, At, B0); PG8_BAR; PG8_SCHED;
            PG8_STAGE(PG8_SB(1, 1), b3 + hstep, voffB);
            PG8_WAIT_V(6); PG8_BAR; PG8_MMA(1, 1, At, B1); PG8_BAR;
            }
        }
        if constexpr (ALIGN_EPI) { if (wr == 0) PG8_BAR; }
        if constexpr (!Epi::AFTER_DRAIN) { E(acc, cur, wr, wc, fr, fq);
#if defined(EPIPROBE) && EPIPROBE
            if constexpr (Epi::IDEMP) { asm volatile("" ::: "memory"); E(acc, cur, wr, wc, fr, fq); }
#endif
            S.done(cur); }
        if (!has_next) break;
#pragma unroll
        for (int a = 0; a < 2; ++a)
#pragma unroll
            for (int b = 0; b < 2; ++b)
#pragma unroll
                for (int m = 0; m < 4; ++m)
#pragma unroll
                    for (int n = 0; n < 2; ++n) acc[a][b][m][n] = (f32x4){0.f, 0.f, 0.f, 0.f};
        cur = nxt; cA = nA; cB = nB; ++ui;
        if constexpr (ALIGN_EPI) { if (wr == 1) PG8_BAR; }
    }
    PG8_WAIT_V(0);
    if constexpr (!ALIGN_EPI) { if (wr == 0) PG8_BAR; }
    PG8_BAR;
    if constexpr (Epi::AFTER_DRAIN) { E.fused(acc, cur, wr, wc, fr, fq, lds, wid, lane); S.done(cur); }
#undef PG8_SA
#undef PG8_SB
#undef PG8_STAGE
#undef PG8_LDA
#undef PG8_LDB
#undef PG8_MMA
#undef PG8_WAIT_V
#undef PG8_WAIT_L
#undef PG8_BAR
#undef PG8_SCHED
}
}
#define XB_TMO      128
#define XB_XCNT(j)  (256  + 64 * (j))
#define XB_XSUB(j)  (1280 + 64 * (j))
#define XB_XGEN(j)  (2304 + 64 * (j))
#define XB_TOP      3328
#define XB_TOPGEN   3392
#define XCD_BAR_WORDS 3456
#define XB_SPIN_CAP (1u << 18)

__device__ __forceinline__ unsigned xb_ld(unsigned* p)              { return __hip_atomic_load(p, __ATOMIC_RELAXED, __HIP_MEMORY_SCOPE_AGENT); }
__device__ __forceinline__ unsigned xb_add(unsigned* p, unsigned v) { return __hip_atomic_fetch_add(p, v, __ATOMIC_RELAXED, __HIP_MEMORY_SCOPE_AGENT); }
__device__ __forceinline__ unsigned xb_xcc_id() { return (unsigned)__builtin_amdgcn_s_getreg((3 << 11) | 20) & 0xFu; }
#define XB_SPIN(cond, bar) do { unsigned _sp = 0; while (cond) { __builtin_amdgcn_s_sleep(1); \
    if ((++_sp & 255u) == 0u) { if (xb_ld(&(bar)[XB_TMO])) break; if (_sp > XB_SPIN_CAP) { atomicAdd(&(bar)[XB_TMO], 1u); break; } } } } while (0)

struct XcdBarrier {
    int wave;
    unsigned* bar; unsigned x;
    volatile LAS unsigned* st;
};

__device__ __forceinline__ XcdBarrier xcd_barrier_post(unsigned* bar, volatile LAS unsigned* st, int wave) {
    XcdBarrier b; b.wave = wave; b.bar = bar; b.x = xb_xcc_id(); b.st = st;
    if (wave == 0 && lane_id() == 0) (void)xb_add(&bar[XB_XCNT(b.x)], 1u);
    return b;
}
__device__ __forceinline__ void xcd_barrier_complete(unsigned* bar, unsigned x, unsigned& nloc, unsigned& nx) {
    const unsigned G = gridDim.x * gridDim.y * gridDim.z;
    unsigned sum, cnt, mine, sp = 0u;
    for (;;) {
        sum = 0u; cnt = 0u; mine = 0u;
#pragma unroll
        for (unsigned j = 0; j < 16; ++j) { const unsigned c = xb_ld(&bar[XB_XCNT(j)]); sum += c; cnt += (c > 0u) ? 1u : 0u; mine = (j == x) ? c : mine; }
        if (sum == G) break;
        __builtin_amdgcn_s_sleep(1);
        if ((++sp & 255u) == 0u) { if (xb_ld(&bar[XB_TMO])) break; if (sp > XB_SPIN_CAP) { atomicAdd(&bar[XB_TMO], 1u); break; } }
    }
    nloc = mine > 0u ? mine : 1u; nx = cnt > 0u ? cnt : 1u;
}

__device__ __forceinline__ void xcd_barrier(const XcdBarrier& b) {
    asm volatile("s_waitcnt vmcnt(0)" ::: "memory");
    __syncthreads();
    if (b.wave == 0 && lane_id() == 0) {
        unsigned* bar = b.bar;
        __builtin_amdgcn_s_waitcnt(0);
        unsigned nloc = b.st[0], nx = b.st[1];
        if (nloc == 0u) { xcd_barrier_complete(bar, b.x, nloc, nx); b.st[0] = nloc; b.st[1] = nx; }
        const unsigned tgt = b.st[4] + nx; b.st[4] = tgt;
        const unsigned old = xb_add(&bar[XB_XSUB(b.x)], 1u);
        const unsigned gen = old / nloc;
        bool wait = true;
        if (old + 1u == (gen + 1u) * nloc) {
            __builtin_amdgcn_fence(__ATOMIC_RELEASE, "agent");
            asm volatile("s_waitcnt vmcnt(0)" ::: "memory");
            wait = xb_add(&bar[XB_TOP], 1u) + 1u != tgt;
        }
        if (wait) XB_SPIN(xb_ld(&bar[XB_TOP]) < tgt, bar);
        __builtin_amdgcn_fence(__ATOMIC_ACQUIRE, "agent");
        asm volatile("s_waitcnt vmcnt(0)" ::: "memory");
    }
    __syncthreads();
}
constexpr int NWAVES = 8, NTHR = 512;
constexpr int RING_BYTES = 131072;
constexpr int WSLICE = 19456;
constexpr int MISC_OFF = NWAVES * WSLICE;
constexpr int LDS_BYTES = MISC_OFF + 512;
static_assert(MISC_OFF >= RING_BYTES && LDS_BYTES <= 163840, "LDS map");
#define LDS_WAIT() asm volatile("s_waitcnt lgkmcnt(0)" ::: "memory")
#define VM_WAIT() asm volatile("s_waitcnt vmcnt(0)" ::: "memory")

struct Args { const void* in[25]; float* out; unsigned char* ws; int ph_lo, ph_hi, li, pad; };

constexpr int PH_PRO = 0, PH_KV = 1, PH_L0 = 2, PH_PER_LAYER = 13, PH_FINAL = PH_L0 + DEPTH * PH_PER_LAYER, PH_END = PH_FINAL + 1;
enum { LP_CONV = 0, LP_GUA, LP_DNA, LP_WIN, LP_MIXA, LP_SCAN, LP_MIXB, LP_WOUT, LP_XQ, LP_ATT, LP_XO, LP_GUB, LP_DNB };

DI void conv_item(const float* W, int ldw, int K, int NP, int nvalid, int mapk, const float* gk, bf16* WT, LAS float* scr, int item, int lane) {
    const int nblk = NP / 64, kb = item / nblk, nb = item % nblk, k0 = 64 * kb, n0 = 64 * nb;
    const int np = n0 + lane;
    int src = np; bool ok = np < nvalid;
    if (mapk == 1) { const int tile = np >> 8, t = np & 255; src = (t < 128) ? (128 * tile + t) : (DFF + 128 * tile + (t - 128)); ok = true; }
    const float* wp = W + (size_t)k0 * ldw + (ok ? src : 0);
#pragma unroll
    for (int h = 0; h < 2; ++h) { float w[32];
#pragma unroll
        for (int i = 0; i < 32; ++i) w[i] = wp[(size_t)(32 * h + i) * ldw];
#pragma unroll
        for (int i = 0; i < 32; ++i) { float v = ok ? w[i] : 0.f; if (gk) v *= gk[k0 + 32 * h + i]; scr[(32 * h + i) * 65 + lane] = v; } }
    LDS_WAIT();
    const int c = lane & 7;
#pragma unroll
    for (int j = 0; j < 8; ++j) { const int n = (lane >> 3) + 8 * j; const LAS float* s = scr + (8 * c) * 65 + n;
        u32x4 o; o.x = pk2(s[0 * 65], s[1 * 65]); o.y = pk2(s[2 * 65], s[3 * 65]); o.z = pk2(s[4 * 65], s[5 * 65]); o.w = pk2(s[6 * 65], s[7 * 65]);
        *(u32x4*)(WT + (size_t)(n0 + n) * K + k0 + 8 * c) = o; }
    LDS_WAIT();
}
DI int sel8(int j, int a0, int a1, int a2, int a3, int a4, int a5, int a6, int a7) { return j == 0 ? a0 : j == 1 ? a1 : j == 2 ? a2 : j == 3 ? a3 : j == 4 ? a4 : j == 5 ? a5 : j == 6 ? a6 : a7; }
DI const void* argp(const Args& a, int i) { asm volatile("" : "+s"(i)); return a.in[i]; }
enum { I_X = 0, I_MEM, I_POS, I_GFFA, I_WFFAGU, I_WFFADN, I_GMIX, I_WIN, I_GLAWA2, I_GLABA, I_GLAGN, I_RETGN, I_MLCONV, I_MLBI, I_MLBF, I_WOUT, I_GXA, I_GMEM, I_WXQ, I_WXKV, I_WXO, I_GFFB, I_WFFBGU, I_WFFBDN, I_GFINAL };
DI unsigned char* wl_base(const Args& args, int l) { return (l & 1) ? (unsigned char*)args.out : args.ws + WS_WL; }
DI void convert_layer(const Args& args, int l, LAS float* scr, int gw, int ngw, int lane) {
    constexpr int C_GU = (D / 64) * (2 * DFF / 64), C_DN = (DFF / 64) * (D / 64), C_IN = (D / 64) * (DINP / 64), C_SQ = (D / 64) * (D / 64);
    constexpr int NITEMS = 2 * C_GU + 2 * C_DN + C_IN + 3 * C_SQ;
    constexpr int cnt[8] = {C_GU, C_GU, C_DN, C_DN, C_IN, C_SQ, C_SQ, C_SQ};
    for (int it = gw; it < NITEMS; it += ngw) {
        int r = it, j = 0;
#pragma unroll
        for (int q = 0; q < 7; ++q) { if (j == q && r >= cnt[q]) { r -= cnt[q]; j = q + 1; } }
        const int in_idx = sel8(j, I_WFFAGU, I_WFFBGU, I_WFFADN, I_WFFBDN, I_WIN, I_WOUT, I_WXQ, I_WXO);
        const int g_idx = sel8(j, I_GFFA, I_GFFB, -1, -1, I_GMIX, -1, I_GXA, -1);
        const int ldw = sel8(j, 2 * DFF, 2 * DFF, D, D, DIN, D, D, D), K = sel8(j, D, D, DFF, DFF, D, D, D, D), NP = sel8(j, 2 * DFF, 2 * DFF, D, D, DINP, D, D, D);
        const int mapk = j < 2 ? 1 : 0;
        const size_t dst = j == 0 ? WL_GUA : j == 1 ? WL_GUB : j == 2 ? WL_DNA : j == 3 ? WL_DNB : j == 4 ? WL_IN : j == 5 ? WL_OUT : j == 6 ? WL_XQ : WL_XO;
        const float* W = (const float*)args.in[in_idx] + (size_t)l * K * ldw;
        const float* gk = g_idx >= 0 ? (const float*)args.in[g_idx >= 0 ? g_idx : 0] + l * D : nullptr;
        conv_item(W, ldw, K, NP, ldw, mapk, gk, (bf16*)(wl_base(args, l) + dst), scr, r, lane);
    }
}
DI void convert_kv(const Args& args, LAS float* scr, int gw, int ngw, int lane) {
    constexpr int C_KV = (D / 64) * (2048 / 64);
    const float* wkv = (const float*)argp(args, I_WXKV); const float* gm = (const float*)argp(args, I_GMEM);
    for (int it = gw; it < DEPTH * C_KV; it += ngw) { const int l = it / C_KV, r = it % C_KV;
        conv_item(wkv + (size_t)l * D * 2048, 2048, D, 2048, 2048, 0, gm + l * D, (bf16*)(args.ws + WS_WKV) + (size_t)l * 2048 * D, scr, r, lane); }
}
template <int RB>
DI void stats_rows(const float* x, bf16* xb, float* part, int m0, int mstep, int mend, int lane) {
    for (int m = m0; m < mend; m += RB * mstep) { f32x4 v[RB][4];
#pragma unroll
        for (int r = 0; r < RB; ++r) { const int mm = (m + r * mstep < mend) ? m + r * mstep : m; const f32x4* xr = (const f32x4*)(x + (size_t)mm * D);
#pragma unroll
            for (int j = 0; j < 4; ++j) v[r][j] = xr[lane + 64 * j]; }
#pragma unroll
        for (int r = 0; r < RB; ++r) { const int mm = m + r * mstep; float s = 0.f;
#pragma unroll
            for (int j = 0; j < 4; ++j) s += (v[r][j].x * v[r][j].x + v[r][j].y * v[r][j].y) + (v[r][j].z * v[r][j].z + v[r][j].w * v[r][j].w);
            s = wave_sum(s);
            if (mm < mend) {
#pragma unroll
                for (int j = 0; j < 4; ++j) { uint2 o; o.x = pk2(v[r][j].x, v[r][j].y); o.y = pk2(v[r][j].z, v[r][j].w); *(uint2*)(xb + (size_t)mm * D + (lane + 64 * j) * 4) = o; }
                if (lane < 16) part[(size_t)mm * 16 + lane] = (lane == 0) ? s : 0.f; } } }
}
#define GB_BASE    4096
#define GB_CNT(s)  (GB_BASE + 64 * (s))
#define GB_MASK(g) (GB_BASE + 4096 + 64 * (g))
static_assert(XCD_BAR_WORDS <= GB_BASE && (size_t)(GB_BASE + 4096 + 512) * 4 <= CTL_ZERO_BYTES, "control words");
DI void grp_post(const XcdBarrier& b) { if (b.wave == 0 && lane_id() == 0) (void)__hip_atomic_fetch_or(&b.bar[GB_MASK(blockIdx.x & 7u)], 1u << b.x, __ATOMIC_RELAXED, __HIP_MEMORY_SCOPE_AGENT); }
DI void grp_decide(const XcdBarrier& b, int G) {
    if (b.wave == 0 && lane_id() == 0) { unsigned ok = (G == 256) ? 1u : 0u;
        for (int g = 0; g < 8; ++g) { const unsigned m = xb_ld(&b.bar[GB_MASK(g)]); ok &= (m != 0u && (m & (m - 1u)) == 0u) ? 1u : 0u; }
        b.st[2] = ok ? 1u : 2u; }
    __syncthreads();
}
DI void grp_barrier(const XcdBarrier& b) {
    if (b.st[2] != 1u) { xcd_barrier(b); return; }
    asm volatile("s_waitcnt vmcnt(0)" ::: "memory");
    __syncthreads();
    if (b.wave == 0 && lane_id() == 0) {
        unsigned* cw = &b.bar[GB_CNT((blockIdx.x & 7u) * 8u + ((blockIdx.x >> 3) & 7u))];
        const unsigned tgt = b.st[3] + 4u; b.st[3] = tgt;
        __builtin_amdgcn_s_waitcnt(0);
        const unsigned old = xb_add(cw, 1u);
        if (old + 1u != tgt) XB_SPIN(xb_ld(cw) < tgt, b.bar);
        __builtin_amdgcn_fence(__ATOMIC_ACQUIRE, "agent");
        asm volatile("s_waitcnt vmcnt(0)" ::: "memory");
    }
    __syncthreads();
}
DI void loc_barrier(const XcdBarrier& b) {
    if (b.st[2] != 1u) { xcd_barrier(b); return; }
    asm volatile("s_waitcnt vmcnt(0)" ::: "memory");
    __syncthreads();
    if (b.wave == 0 && lane_id() == 0) { __builtin_amdgcn_fence(__ATOMIC_ACQUIRE, "agent"); asm volatile("s_waitcnt vmcnt(0)" ::: "memory"); }
    __syncthreads();
}
struct MixCtx { unsigned char* ws; const float *w_a2, *b_a, *gla_gn, *ret_gn, *conv, *b_i, *b_f; };
#ifndef MIXPROBE
#define MIXPROBE 0
#endif
#define LDS_FENCE() __builtin_amdgcn_fence(__ATOMIC_SEQ_CST, "wavefront", "local")
constexpr int NCH = SEQ / 64;
constexpr size_t ST_G = WS_ST, ST_R = WS_ST + 12 * MiB, ST_M = WS_ST + 24 * MiB, ST_GDEC = WS_ST + 41 * MiB, ST_MLSC = WS_ST + 42 * MiB;
constexpr int ML_BLK = 65 * 64;
static_assert(ST_M + (size_t)16 * NCH * ML_BLK * 2 <= ST_GDEC && ST_MLSC + (size_t)16 * NCH * 16 <= WS_Y, "state map");
constexpr float QK_SCALE32 = 0.17677669529663687f;

DI const bf16* prow(const bf16* P, size_t row) { return P + ((row >> 6) * (size_t)(DINP / 16) * 64 + (row & 63)) * 16; }
DI const bf16* pcol(const bf16* pr, int col) { return pr + (col >> 4) * 1024 + (col & 15); }
DI float blo(unsigned u) { return __uint_as_float(u << 16); }
DI float bhi(unsigned u) { return __uint_as_float(u & 0xffff0000u); }
DI void ld8(const bf16* p, float* o) { const uint4 v = *(const uint4*)p; o[0] = blo(v.x); o[1] = bhi(v.x); o[2] = blo(v.y); o[3] = bhi(v.y); o[4] = blo(v.z); o[5] = bhi(v.z); o[6] = blo(v.w); o[7] = bhi(v.w); }
DI f32x16 mfma32(bf16x8 a, bf16x8 b, f32x16 c) { return __builtin_amdgcn_mfma_f32_32x32x16_bf16(a, b, c, 0, 0, 0); }
DI bf16x8 lfrag(const LAS bf16* base, int ld, int row0, int k0, int lane) { return *(const LAS bf16x8*)(base + (row0 + (lane & 31)) * ld + k0 + 8 * (lane >> 5)); }
DI bf16x8 gfrag(const bf16* base, int ld, int row0, int k0, int lane) { return *(const bf16x8*)(base + (size_t)(row0 + (lane & 31)) * ld + k0 + 8 * (lane >> 5)); }
DI int crow(int reg, int hf) { return (reg & 3) + 8 * (reg >> 2) + 4 * hf; }
DI f32x16 zero16() { f32x16 z; for (int i = 0; i < 16; ++i) z[i] = 0.f; return z; }
template <int CTRL, int ROWMASK> DI float dpp_f(float old, float x) { return __builtin_bit_cast(float, __builtin_amdgcn_update_dpp(__builtin_bit_cast(int, old), __builtin_bit_cast(int, x), CTRL, ROWMASK, 0xf, false)); }
DI float scan_add(float x, int) {
    x += dpp_f<0x111, 0xf>(0.f, x); x += dpp_f<0x112, 0xf>(0.f, x); x += dpp_f<0x114, 0xf>(0.f, x); x += dpp_f<0x118, 0xf>(0.f, x);
    x += dpp_f<0x142, 0xa>(0.f, x); x += dpp_f<0x143, 0xc>(0.f, x);
    return x;
}
DI float scan_max(float x, int) {
    const float ninf = -__builtin_inff();
    x = fmaxf(x, dpp_f<0x111, 0xf>(ninf, x)); x = fmaxf(x, dpp_f<0x112, 0xf>(ninf, x)); x = fmaxf(x, dpp_f<0x114, 0xf>(ninf, x)); x = fmaxf(x, dpp_f<0x118, 0xf>(ninf, x));
    x = fmaxf(x, dpp_f<0x142, 0xa>(ninf, x)); x = fmaxf(x, dpp_f<0x143, 0xc>(ninf, x));
    return x;
}
DI u32x4 pk8(const float* v) { u32x4 w; w.x = pk2(v[0], v[1]); w.y = pk2(v[2], v[3]); w.z = pk2(v[4], v[5]); w.w = pk2(v[6], v[7]); return w; }
DI void stage_vt(const bf16* p, int col, LAS bf16* VT, int lane) {
#pragma unroll
    for (int q = 0; q < 8; ++q) { const uint4 w = *(const uint4*)pcol(p, col + 8 * q); const unsigned u[4] = {w.x, w.y, w.z, w.w};
#pragma unroll
        for (int e = 0; e < 4; ++e) { VT[(8 * q + 2 * e) * 72 + lane] = (bf16)(u[e] & 0xffffu); VT[(8 * q + 2 * e + 1) * 72 + lane] = (bf16)(u[e] >> 16); } }
}
DI void gla_logdecay(const float* w_a2, const float* b_a, int h, const bf16* p, float* la) {
    float ga[16]; ld8(pcol(p, C_GA), ga); ld8(pcol(p, C_GA + 8), ga + 8);
#pragma unroll
    for (int c = 0; c < 32; ++c) la[c] = b_a[h * 32 + c];
#pragma unroll
    for (int r = 0; r < 16; ++r)
#pragma unroll
        for (int c = 0; c < 32; ++c) la[c] += ga[r] * w_a2[r * 192 + h * 32 + c];
#pragma unroll
    for (int c = 0; c < 32; ++c) la[c] = logsigf_(la[c]) * (1.4426950408889634f / 16.f);
}
DI void rot_row(const bf16* p, int col, const float2* cs, float scale, float* o) {
    float x[32];
#pragma unroll
    for (int q = 0; q < 4; ++q) ld8(pcol(p, col + 8 * q), x + 8 * q);
#pragma unroll
    for (int m = 0; m < 16; ++m) { const float2 c = cs[m]; o[m] = (x[m] * c.x - x[m + 16] * c.y) * scale; o[m + 16] = (x[m] * c.y + x[m + 16] * c.x) * scale; }
}

template <bool RET>
DI void gr_passA(const MixCtx& cx, int b, int h, int ch, LAS unsigned char* sl, int lane) {
    const int t = ch * 64 + lane; const size_t row = (size_t)b * SEQ + t; const bf16* p = prow((const bf16*)(cx.ws + WS_P), row);
    LAS bf16* KT = (LAS bf16*)sl; LAS bf16* VT = (LAS bf16*)(sl + 9216);
    const int item = (b * 6 + h) * NCH + ch;
    float k[32];
    if (!RET) {
        float bc[32];
        gla_logdecay(cx.w_a2, cx.b_a, h, p, bc);
#pragma unroll
        for (int c = 0; c < 32; ++c) bc[c] = scan_add(bc[c], lane);
#pragma unroll
        for (int q = 0; q < 4; ++q) ld8(pcol(p, C_GK + h * 32 + 8 * q), k + 8 * q);
#pragma unroll
        for (int c = 0; c < 32; ++c) { const float bl = __shfl(bc[c], 63); k[c] *= __builtin_amdgcn_exp2f(bl - bc[c]); bc[c] = __builtin_amdgcn_exp2f(bl); }
        if (lane == 0) { float* gd = (float*)(cx.ws + ST_GDEC) + (size_t)item * 32;
#pragma unroll
            for (int q = 0; q < 8; ++q) *(f32x4*)(gd + 4 * q) = (f32x4){bc[4 * q], bc[4 * q + 1], bc[4 * q + 2], bc[4 * q + 3]}; }
    } else {
        const float lg = __logf(1.f - exp2f(-5.f - (float)h));
        rot_row(p, C_RK + h * 32, (const float2*)(cx.ws + WS_ROPE) + row * 16, QK_SCALE32 * __expf((float)(63 - lane) * lg), k);
    }
#pragma unroll
    for (int c = 0; c < 32; ++c) KT[c * 72 + lane] = f2bf(k[c]);
    stage_vt(p, (RET ? C_RV : C_GV) + h * 64, VT, lane);
    LDS_FENCE();
    f32x16 a0 = zero16(), a1 = zero16();
#pragma unroll
    for (int ks = 0; ks < 4; ++ks) { const bf16x8 bk = lfrag(KT, 72, 0, ks * 16, lane);
        a0 = mfma32(lfrag(VT, 72, 0, ks * 16, lane), bk, a0); a1 = mfma32(lfrag(VT, 72, 32, ks * 16, lane), bk, a1); }
    bf16* st = (bf16*)(cx.ws + (RET ? ST_R : ST_G)) + (size_t)item * 2048;
    const int hf = lane >> 5, r32 = lane & 31;
#pragma unroll
    for (int r = 0; r < 16; ++r) { st[crow(r, hf) * 32 + r32] = f2bf(a0[r]); st[(32 + crow(r, hf)) * 32 + r32] = f2bf(a1[r]); }
    LDS_FENCE();
}

template <bool RET, int STOP = 0>
DI void gr_passB(const MixCtx& cx, int b, int h, int ch, LAS unsigned char* sl, int lane) {
    const int t = ch * 64 + lane; const size_t row = (size_t)b * SEQ + t; const bf16* p = prow((const bf16*)(cx.ws + WS_P), row);
    LAS bf16* QS = (LAS bf16*)sl; LAS bf16* KS = (LAS bf16*)(sl + 4096); LAS bf16* VT = (LAS bf16*)(sl + 9216); LAS bf16* PS = (LAS bf16*)sl; LAS float* OS = (LAS float*)sl;
    const int item = (b * 6 + h) * NCH + ch; const int hf = lane >> 5, r32 = lane & 31;
    const bf16* st = (const bf16*)(cx.ws + (RET ? ST_R : ST_G)) + (size_t)item * 2048;
    bf16x8 gst[2][2]; u32x4 gq[8];
#pragma unroll
    for (int ks = 0; ks < 2; ++ks) { gst[0][ks] = gfrag(st, 32, 0, ks * 16, lane); gst[1][ks] = gfrag(st, 32, 32, ks * 16, lane); }
#pragma unroll
    for (int q = 0; q < 8; ++q) gq[q] = *(const u32x4*)pcol(p, (RET ? C_RG : C_GR) + h * 64 + 8 * q);
    stage_vt(p, (RET ? C_RV : C_GV) + h * 64, VT, lane);
    {
        float q[32], k[32];
        if (!RET) {
            float bc[32];
            gla_logdecay(cx.w_a2, cx.b_a, h, p, bc);
    #pragma unroll
        for (int c = 0; c < 32; ++c) bc[c] = scan_add(bc[c], lane);
#pragma unroll
            for (int qq = 0; qq < 4; ++qq) { ld8(pcol(p, C_GQ + h * 32 + 8 * qq), q + 8 * qq); ld8(pcol(p, C_GK + h * 32 + 8 * qq), k + 8 * qq); }
#pragma unroll
            for (int c = 0; c < 32; ++c) { q[c] *= QK_SCALE32 * __builtin_amdgcn_exp2f(bc[c]); k[c] *= __builtin_amdgcn_exp2f(-bc[c]); }
        } else {
            const float lg = __logf(1.f - exp2f(-5.f - (float)h)); const float2* cs = (const float2*)(cx.ws + WS_ROPE) + row * 16;
            rot_row(p, C_RQ + h * 32, cs, __expf((float)(lane + 1) * lg), q);
            rot_row(p, C_RK + h * 32, cs, QK_SCALE32 * __expf(-(float)(lane + 1) * lg), k);
        }
#pragma unroll
        for (int qq = 0; qq < 4; ++qq) { *(LAS u32x4*)(QS + lane * 32 + 8 * qq) = pk8(q + 8 * qq); *(LAS u32x4*)(KS + lane * 32 + 8 * qq) = pk8(k + 8 * qq); }
    }
    LDS_FENCE();
    if (STOP == 1) return;
    f32x16 s00 = zero16(), s10 = zero16(), s11 = zero16();
    bf16x8 qa[2][2];
#pragma unroll
    for (int ks = 0; ks < 2; ++ks) {
        qa[0][ks] = lfrag(QS, 32, 0, ks * 16, lane); qa[1][ks] = lfrag(QS, 32, 32, ks * 16, lane);
        const bf16x8 b0 = lfrag(KS, 32, 0, ks * 16, lane), b1 = lfrag(KS, 32, 32, ks * 16, lane);
        s00 = mfma32(qa[0][ks], b0, s00); s10 = mfma32(qa[1][ks], b0, s10); s11 = mfma32(qa[1][ks], b1, s11);
    }
    LDS_FENCE();
#pragma unroll
    for (int r = 0; r < 16; ++r) { const int i0 = crow(r, hf); const bool keep = r32 <= i0;
        PS[i0 * 72 + r32] = f2bf(keep ? s00[r] : 0.f); PS[(32 + i0) * 72 + r32] = f2bf(s10[r]); PS[(32 + i0) * 72 + 32 + r32] = f2bf(keep ? s11[r] : 0.f); }
    f32x16 o00 = zero16(), o01 = zero16(), o10 = zero16(), o11 = zero16();
#pragma unroll
    for (int ks = 0; ks < 2; ++ks) { const bf16x8 g0 = gst[0][ks], g1 = gst[1][ks];
        o00 = mfma32(qa[0][ks], g0, o00); o01 = mfma32(qa[0][ks], g1, o01); o10 = mfma32(qa[1][ks], g0, o10); o11 = mfma32(qa[1][ks], g1, o11); }
    LDS_FENCE();
    if (STOP == 2) { asm volatile("" :: "v"(o00[0] + o01[0] + o10[0] + o11[0])); return; }
#pragma unroll
    for (int ks = 0; ks < 4; ++ks) { const bf16x8 v0 = lfrag(VT, 72, 0, ks * 16, lane), v1 = lfrag(VT, 72, 32, ks * 16, lane);
        if (ks < 2) { const bf16x8 a0 = lfrag(PS, 72, 0, ks * 16, lane); o00 = mfma32(a0, v0, o00); o01 = mfma32(a0, v1, o01); }
        const bf16x8 a1 = lfrag(PS, 72, 32, ks * 16, lane); o10 = mfma32(a1, v0, o10); o11 = mfma32(a1, v1, o11); }
    LDS_FENCE();
#pragma unroll
    for (int r = 0; r < 16; ++r) { const int i0 = crow(r, hf); OS[i0 * 68 + r32] = o00[r]; OS[i0 * 68 + 32 + r32] = o01[r]; OS[(32 + i0) * 68 + r32] = o10[r]; OS[(32 + i0) * 68 + 32 + r32] = o11[r]; }
    LDS_FENCE();
    float o[64];
#pragma unroll
    for (int q = 0; q < 16; ++q) { const f32x4 v = *(const LAS f32x4*)(OS + lane * 68 + 4 * q); o[4 * q] = v.x; o[4 * q + 1] = v.y; o[4 * q + 2] = v.z; o[4 * q + 3] = v.w; }
    float mu = 0.f, ss = 0.f;
    if (RET) {
#pragma unroll
        for (int c = 0; c < 64; ++c) mu += o[c];
        mu *= (1.f / 64.f); }
#pragma unroll
    for (int c = 0; c < 64; ++c) { o[c] -= mu; ss += o[c] * o[c]; }
    const float rn = rsqrtf(ss * (1.f / 64.f) + EPS);
    const float* gn = (RET ? cx.ret_gn : cx.gla_gn) + h * 64;
    bf16* yp = (bf16*)(cx.ws + WS_Y) + row * D + (RET ? 384 : 0) + h * 64;
#pragma unroll
    for (int q = 0; q < 8; ++q) { float y[8]; const float g[8] = {blo(gq[q].x), bhi(gq[q].x), blo(gq[q].y), bhi(gq[q].y), blo(gq[q].z), bhi(gq[q].z), blo(gq[q].w), bhi(gq[q].w)};
#pragma unroll
        for (int e = 0; e < 8; ++e) y[e] = o[8 * q + e] * rn * gn[8 * q + e] * siluf_(g[e]);
        *(u32x4*)(yp + 8 * q) = pk8(y); }
    LDS_FENCE();
}

template <int NC>
DI void ml_conv_row(const bf16* P, size_t row, int t, int col, const float* w, int wch, float scale, float* o) {
    u32x4 x[4][NC / 8];
    const bool first = __builtin_amdgcn_readfirstlane(t) < 64;
#pragma unroll
    for (int j = 0; j < 4; ++j) { const bf16* pp = prow(P, (first && t - 3 + j < 0) ? row : row - 3 + j);
#pragma unroll
        for (int q = 0; q < NC / 8; ++q) x[j][q] = *(const u32x4*)pcol(pp, col + 8 * q); }
    if (first) {
#pragma unroll
        for (int j = 0; j < 3; ++j) { if (t - 3 + j < 0) {
#pragma unroll
                for (int q = 0; q < NC / 8; ++q) x[j][q] = (u32x4){0u, 0u, 0u, 0u}; } } }
#pragma unroll
    for (int c = 0; c < NC; ++c) o[c] = 0.f;
#pragma unroll
    for (int j = 0; j < 4; ++j)
#pragma unroll
        for (int q = 0; q < NC / 8; ++q) { const u32x4 v = x[j][q]; const float* wj = w + j * 512 + wch + 8 * q;
            o[8 * q + 0] += wj[0] * blo(v.x); o[8 * q + 1] += wj[1] * bhi(v.x); o[8 * q + 2] += wj[2] * blo(v.y); o[8 * q + 3] += wj[3] * bhi(v.y);
            o[8 * q + 4] += wj[4] * blo(v.z); o[8 * q + 5] += wj[5] * bhi(v.z); o[8 * q + 6] += wj[6] * blo(v.w); o[8 * q + 7] += wj[7] * bhi(v.w); }
#pragma unroll
    for (int c = 0; c < NC; ++c) o[c] = siluf_(o[c]) * scale;
}
DI void ml_passA(const MixCtx& cx, int b, int h, int ch, LAS unsigned char* sl, int lane) {
    const int t = ch * 64 + lane; const size_t row = (size_t)b * SEQ + t; const bf16* P = (const bf16*)(cx.ws + WS_P); const bf16* p = prow(P, row);
    LAS bf16* KT = (LAS bf16*)sl; LAS bf16* VT = (LAS bf16*)(sl + 9216);
    const int item = (b * 4 + h) * NCH + ch; const int hf = lane >> 5, r32 = lane & 31;
    const float ii = bf2f(*pcol(p, C_MI + h)) + cx.b_i[h];
    const float lf = logsigf_(bf2f(*pcol(p, C_MF + h)) + cx.b_f[h]);
    const float bcum = scan_add(lf, lane), blast = __shfl(bcum, 63);
    const float lw = blast - bcum + ii, mloc = wave_max(lw), wgt = __expf(lw - mloc);
#pragma unroll
    for (int hh = 0; hh < 2; ++hh) {
        float k[32];
        ml_conv_row<32>(P, row, t, C_MK + h * 64 + 32 * hh, cx.conv, 256 + h * 64 + 32 * hh, 0.125f * wgt, k);
#pragma unroll
        for (int c = 0; c < 32; ++c) KT[(32 * hh + c) * 72 + lane] = f2bf(k[c]);
    }
    stage_vt(p, C_MV + h * 64, VT, lane);
    LDS_FENCE();
    f32x16 c00 = zero16(), c01 = zero16(), c10 = zero16(), c11 = zero16();
#pragma unroll
    for (int ks = 0; ks < 4; ++ks) { const bf16x8 a0 = lfrag(VT, 72, 0, ks * 16, lane), a1 = lfrag(VT, 72, 32, ks * 16, lane), b0 = lfrag(KT, 72, 0, ks * 16, lane), b1 = lfrag(KT, 72, 32, ks * 16, lane);
        c00 = mfma32(a0, b0, c00); c01 = mfma32(a0, b1, c01); c10 = mfma32(a1, b0, c10); c11 = mfma32(a1, b1, c11); }
    bf16* st = (bf16*)(cx.ws + ST_M) + (size_t)item * ML_BLK;
#pragma unroll
    for (int r = 0; r < 16; ++r) { const int v0 = crow(r, hf);
        st[v0 * 64 + r32] = f2bf(c00[r]); st[v0 * 64 + 32 + r32] = f2bf(c01[r]); st[(32 + v0) * 64 + r32] = f2bf(c10[r]); st[(32 + v0) * 64 + 32 + r32] = f2bf(c11[r]); }
    { float s = 0.f;
#pragma unroll
      for (int q = 0; q < 8; ++q) { const u32x4 w = *(const LAS u32x4*)(KT + lane * 72 + 8 * q); s += (blo(w.x) + bhi(w.x)) + (blo(w.y) + bhi(w.y)) + (blo(w.z) + bhi(w.z)) + (blo(w.w) + bhi(w.w)); }
      st[64 * 64 + lane] = f2bf(s); }
    if (lane == 0) { float* sc = (float*)(cx.ws + ST_MLSC) + (size_t)item * 4; sc[0] = blast; sc[1] = mloc; }
    LDS_FENCE();
}
template <int STOP = 0>
DI void ml_passB(const MixCtx& cx, int b, int h, int ch, LAS unsigned char* sl, int lane) {
    const int t = ch * 64 + lane; const size_t row = (size_t)b * SEQ + t; const bf16* P = (const bf16*)(cx.ws + WS_P); const bf16* p = prow(P, row);
    LAS bf16* R1 = (LAS bf16*)sl; LAS bf16* R2 = (LAS bf16*)(sl + 9216); LAS float* OS = (LAS float*)sl;
    const int item = (b * 4 + h) * NCH + ch; const int hf = lane >> 5, r32 = lane & 31;
    const float* cw = cx.conv;
    const bf16* st = (const bf16*)(cx.ws + ST_M) + (size_t)item * ML_BLK;
    const float mst = ((const float*)(cx.ws + ST_MLSC))[(size_t)item * 4 + 2];
    const float ii = bf2f(*pcol(p, C_MI + h)) + cx.b_i[h];
    const float lf = logsigf_(bf2f(*pcol(p, C_MF + h)) + cx.b_f[h]);
    const float bcum = scan_add(lf, lane);
    const float u = ii - bcum, pm = scan_max(u, lane), U = __shfl(pm, 63);
    const float mx = fmaxf(mst, pm), mi = bcum + mx, winter = __expf(mst - mx), Ai = __expf(U - mx), Bj = __expf(u - U);
    float den = 0.f;
#pragma unroll
    for (int hh = 0; hh < 2; ++hh) {
        float q[32];
        ml_conv_row<32>(P, row, t, C_MQ + h * 64 + 32 * hh, cw, h * 64 + 32 * hh, 1.f, q);
#pragma unroll
        for (int qq = 0; qq < 4; ++qq) { float n[8], a[8], w[8]; ld8(st + 64 * 64 + 32 * hh + 8 * qq, n);
#pragma unroll
            for (int e = 0; e < 8; ++e) { den += q[8 * qq + e] * n[e]; w[e] = q[8 * qq + e] * winter; a[e] = q[8 * qq + e] * Ai; }
            *(LAS u32x4*)(R1 + lane * 72 + 32 * hh + 8 * qq) = pk8(w); *(LAS u32x4*)(R2 + lane * 72 + 32 * hh + 8 * qq) = pk8(a); }
    }
    den *= winter;
    LDS_FENCE();
    if (STOP == 1) { asm volatile("" :: "v"(den)); return; }
    bf16x8 qw[2][4];
#pragma unroll
    for (int ks = 0; ks < 4; ++ks) { qw[0][ks] = lfrag(R1, 72, 0, ks * 16, lane); qw[1][ks] = lfrag(R1, 72, 32, ks * 16, lane); }
    LDS_FENCE();
#pragma unroll
    for (int hh = 0; hh < 4; ++hh) {
        float k[16];
        ml_conv_row<16>(P, row, t, C_MK + h * 64 + 16 * hh, cw, 256 + h * 64 + 16 * hh, 0.125f * Bj, k);
#pragma unroll
        for (int qq = 0; qq < 2; ++qq) *(LAS u32x4*)(R1 + lane * 72 + 16 * hh + 8 * qq) = pk8(k + 8 * qq);
    }
    LDS_FENCE();
    f32x16 s00 = zero16(), s10 = zero16(), s11 = zero16();
#pragma unroll
    for (int ks = 0; ks < 4; ++ks) { const bf16x8 a0 = lfrag(R2, 72, 0, ks * 16, lane), a1 = lfrag(R2, 72, 32, ks * 16, lane), b0 = lfrag(R1, 72, 0, ks * 16, lane), b1 = lfrag(R1, 72, 32, ks * 16, lane);
        s00 = mfma32(a0, b0, s00); s10 = mfma32(a1, b0, s10); s11 = mfma32(a1, b1, s11); }
    LDS_FENCE();
#pragma unroll
    for (int r = 0; r < 16; ++r) { const int i0 = crow(r, hf); const bool keep = r32 <= i0;
        R1[i0 * 72 + r32] = f2bf(keep ? s00[r] : 0.f); R1[i0 * 72 + 32 + r32] = 0; R1[(32 + i0) * 72 + r32] = f2bf(s10[r]); R1[(32 + i0) * 72 + 32 + r32] = f2bf(keep ? s11[r] : 0.f); }
    f32x16 o00 = zero16(), o01 = zero16(), o10 = zero16(), o11 = zero16();
#pragma unroll
    for (int ks = 0; ks < 4; ++ks) { const bf16x8 g0 = gfrag(st, 64, 0, ks * 16, lane), g1 = gfrag(st, 64, 32, ks * 16, lane);
        o00 = mfma32(qw[0][ks], g0, o00); o01 = mfma32(qw[0][ks], g1, o01); o10 = mfma32(qw[1][ks], g0, o10); o11 = mfma32(qw[1][ks], g1, o11); }
    if (STOP == 2) { asm volatile("" :: "v"(o00[0] + o01[0] + o10[0] + o11[0] + den)); return; }
    stage_vt(p, C_MV + h * 64, R2, lane);
    LDS_FENCE();
    { float s = 0.f;
#pragma unroll
      for (int q = 0; q < 8; ++q) { const u32x4 w = *(const LAS u32x4*)(R1 + lane * 72 + 8 * q); s += (blo(w.x) + bhi(w.x)) + (blo(w.y) + bhi(w.y)) + (blo(w.z) + bhi(w.z)) + (blo(w.w) + bhi(w.w)); }
      den += s; }
#pragma unroll
    for (int ks = 0; ks < 4; ++ks) { const bf16x8 v0 = lfrag(R2, 72, 0, ks * 16, lane), v1 = lfrag(R2, 72, 32, ks * 16, lane);
        if (ks < 2) { const bf16x8 a0 = lfrag(R1, 72, 0, ks * 16, lane); o00 = mfma32(a0, v0, o00); o01 = mfma32(a0, v1, o01); }
        const bf16x8 a1 = lfrag(R1, 72, 32, ks * 16, lane); o10 = mfma32(a1, v0, o10); o11 = mfma32(a1, v1, o11); }
    LDS_FENCE();
#pragma unroll
    for (int r = 0; r < 16; ++r) { const int i0 = crow(r, hf); OS[i0 * 68 + r32] = o00[r]; OS[i0 * 68 + 32 + r32] = o01[r]; OS[(32 + i0) * 68 + r32] = o10[r]; OS[(32 + i0) * 68 + 32 + r32] = o11[r]; }
    LDS_FENCE();
    const float inv = __builtin_amdgcn_rcpf(fmaxf(fabsf(den), __expf(-mi)));
    const int gcol = C_MO + h * 64; bf16* yp = (bf16*)(cx.ws + WS_Y) + row * D + 768 + h * 64;
#pragma unroll
    for (int q = 0; q < 8; ++q) { float g[8], y[8]; ld8(pcol(p, gcol + 8 * q), g);
        const f32x4 oa = *(const LAS f32x4*)(OS + lane * 68 + 8 * q), ob = *(const LAS f32x4*)(OS + lane * 68 + 8 * q + 4); const float o8[8] = {oa.x, oa.y, oa.z, oa.w, ob.x, ob.y, ob.z, ob.w};
#pragma unroll
        for (int e = 0; e < 8; ++e) y[e] = o8[e] * inv * sigmoidf_(g[e]);
        *(u32x4*)(yp + 8 * q) = pk8(y); }
    LDS_FENCE();
}

DI bool mix_item(int k, int wave, int G, int& hs, int& b, int& ch) {
    const int rnd = k >> 2, j = (((k & 3) + wave + (wave >> 2)) & 3) * 8 + wave;
    int t, h0, nh; if (j < 12) { t = j; h0 = 0; nh = 6; } else if (j < 24) { t = j - 12; h0 = 6; nh = 6; } else { t = j - 24; h0 = 12; nh = 4; }
    const int grp = (rnd * G + (int)blockIdx.x) * 2 + t / nh;
    if (grp >= BATCH * NCH) return false;
    hs = h0 + t % nh; b = grp & 3; ch = grp >> 2; return true;
}
DI void mix_passA(const MixCtx& cx, LAS unsigned char* sl, int wave, int G, int lane) {
    for (int k = 0; ; ++k) { int hs, b, ch; if (!mix_item(k, wave, G, hs, b, ch)) break; asm volatile("" : "+v"(lane));
        if (hs < 6) gr_passA<false>(cx, b, hs, ch, sl, lane); else if (hs < 12) gr_passA<true>(cx, b, hs - 6, ch, sl, lane); else ml_passA(cx, b, hs - 12, ch, sl, lane); }
}
DI void mix_passB(const MixCtx& cx, LAS unsigned char* sl, int wave, int G, int lane) {
    for (int k = 0; ; ++k) { int hs, b, ch; if (!mix_item(k, wave, G, hs, b, ch)) break; asm volatile("" : "+v"(lane));
        if (hs < 6) gr_passB<false>(cx, b, hs, ch, sl, lane); else if (hs < 12) gr_passB<true>(cx, b, hs - 6, ch, sl, lane); else ml_passB(cx, b, hs - 12, ch, sl, lane); }
}
DI void mix_scan(const MixCtx& cx, int gtid, int nthr) {
    constexpr int T_GR = 24 * 1024, T_ML = 16 * (ML_BLK / 2);
    for (int task = gtid; task < 2 * T_GR + T_ML; task += nthr) {
        if (task < 2 * T_GR) {
            const bool ret = task >= T_GR; const int tt = ret ? task - T_GR : task; const int seq = tt >> 10, w = tt & 1023;
            unsigned* base = (unsigned*)(cx.ws + (ret ? ST_R : ST_G)) + (size_t)seq * NCH * 1024 + w;
            const float* gd = (const float*)(cx.ws + ST_GDEC) + (size_t)seq * NCH * 32 + ((2 * w) & 31);
            const float gr = __expf(64.f * __logf(1.f - exp2f(-5.f - (float)(seq % 6))));
            float s0 = 0.f, s1 = 0.f;
            for (int c0 = 0; c0 < NCH; c0 += 32) { unsigned dv[32]; float g0[32], g1[32];
#pragma unroll
                for (int j = 0; j < 32; ++j) { dv[j] = base[(size_t)(c0 + j) * 1024]; if (ret) { g0[j] = gr; g1[j] = gr; } else { g0[j] = gd[(c0 + j) * 32]; g1[j] = gd[(c0 + j) * 32 + 1]; } }
#pragma unroll
                for (int j = 0; j < 32; ++j) { base[(size_t)(c0 + j) * 1024] = pk2(s0, s1); s0 = g0[j] * s0 + blo(dv[j]); s1 = g1[j] * s1 + bhi(dv[j]); } }
        } else {
            const int tt = task - 2 * T_GR; const int seq = tt / (ML_BLK / 2), w = tt % (ML_BLK / 2);
            unsigned* base = (unsigned*)(cx.ws + ST_M) + (size_t)seq * NCH * (ML_BLK / 2) + w; float* sc = (float*)(cx.ws + ST_MLSC) + (size_t)seq * NCH * 4;
            float m = 0.f, c0v = 0.f, c1v = 0.f;
            for (int c0 = 0; c0 < NCH; c0 += 32) { unsigned dv[32]; float bl[32], ml[32];
#pragma unroll
                for (int j = 0; j < 32; ++j) { dv[j] = base[(size_t)(c0 + j) * (ML_BLK / 2)]; bl[j] = sc[(c0 + j) * 4]; ml[j] = sc[(c0 + j) * 4 + 1]; }
#pragma unroll
                for (int j = 0; j < 32; ++j) { base[(size_t)(c0 + j) * (ML_BLK / 2)] = pk2(c0v, c1v); if (w == 0) sc[(c0 + j) * 4 + 2] = m;
                    const float mn = fmaxf(bl[j] + m, ml[j]), g = __expf(bl[j] + m - mn), s = __expf(ml[j] - mn);
                    c0v = g * c0v + s * blo(dv[j]); c1v = g * c1v + s * bhi(dv[j]); m = mn; } }
        }
    }
}

constexpr int ATT_LD = 264;
static_assert(256 * ATT_LD * 2 <= MISC_OFF, "attention image fits under the LDS control words");
typedef unsigned u32x2 __attribute__((ext_vector_type(2)));
typedef float f32x2_t __attribute__((ext_vector_type(2)));
typedef __bf16 bf16x2_t __attribute__((ext_vector_type(2)));
DI unsigned cvtpk(float lo, float hi) { const f32x2_t v = {lo, hi}; const bf16x2_t b = __builtin_convertvector(v, bf16x2_t); return __builtin_bit_cast(unsigned, b); }
template <int NB, bool PAIR = false>
DI void att_stage(const bf16* src, size_t src_pitch, LAS bf16* img, int tid) {
#pragma unroll
    for (int b0 = 0; b0 < 16; b0 += NB) { u32x4 v[NB];
#pragma unroll
        for (int it = 0; it < NB; ++it) { const int c = tid + 512 * (b0 + it), r = c >> 5, part = c & 31; v[it] = *(const u32x4*)(src + (size_t)r * src_pitch + part * 8); }
#pragma unroll
        for (int it = 0; it < NB; ++it) { const int c = tid + 512 * (b0 + it), r = c >> 5, part = c & 31, ri = PAIR ? (((r >> 6) * 2 + (r & 1)) * 32 + ((r >> 1) & 31)) : r; *(LAS u32x4*)(img + ri * ATT_LD + part * 8) = v[it]; } }
}
DI void attn_phase(unsigned char* ws, int l, LAS unsigned char* lds, int G, int tid, const int wave) {
    LAS bf16* img = (LAS bf16*)lds;
    const bf16* Q = (const bf16*)(ws + WS_Q); bf16* O = (bf16*)(ws + WS_O);
    const bf16* KBl = (const bf16*)(ws + WS_KB) + (size_t)l * 1024 * 1024; const bf16* VTl = (const bf16*)(ws + WS_VT) + (size_t)l * 4 * 1024 * 256;
    const int gx = blockIdx.x & 7, nj = G >> 3;
    for (int j = blockIdx.x >> 3; j < 64; j += nj) {
        asm volatile("" : "+v"(tid)); const int lane = tid & 63, hf = lane >> 5, r32 = lane & 31;
        const int pm = gx * 16 + (j >> 5) * 8 + (j & 7), hd = (j >> 3) & 3, qt = pm & 31, b = pm >> 5;
        const size_t m0 = (size_t)b * SEQ + qt * 256 + wave * 32;
        const bf16* qb = Q + m0 * D + hd * 256;
        bf16x8 qa[4];
#pragma unroll
        for (int i = 0; i < 4; ++i) qa[i] = gfrag(qb, D, 0, i * 16, lane);
        att_stage<16>(KBl + ((size_t)b * 256) * 1024 + hd * 256, 1024, img, tid);
        __syncthreads();
        f32x16 sa[8];
#pragma unroll
        for (int kt = 0; kt < 8; ++kt) sa[kt] = zero16();
        bf16x8 ka[4], kb[4];
#pragma unroll
        for (int kt = 0; kt < 4; ++kt) ka[kt] = lfrag(img, ATT_LD, kt * 32, 0, lane);
#pragma unroll 1
        for (int g = 0; g < 4; ++g) { bf16x8 qn[4]; const int gn = g < 3 ? g + 1 : 3;
#pragma unroll
            for (int i = 0; i < 4; ++i) qn[i] = gfrag(qb, D, 0, (4 * gn + i) * 16, lane);
#pragma unroll
            for (int i = 0; i < 4; ++i) { const int ks = 4 * g + i, ksn = (ks + 1) & 15;
#pragma unroll
                for (int kt = 0; kt < 4; ++kt) kb[kt] = lfrag(img, ATT_LD, (4 + kt) * 32, ks * 16, lane);
                __builtin_amdgcn_sched_barrier(0);
#pragma unroll
                for (int kt = 0; kt < 4; ++kt) sa[kt] = mfma32(ka[kt], qa[i], sa[kt]);
                __builtin_amdgcn_sched_barrier(0);
#pragma unroll
                for (int kt = 0; kt < 4; ++kt) ka[kt] = lfrag(img, ATT_LD, kt * 32, ksn * 16, lane);
                __builtin_amdgcn_sched_barrier(0);
#pragma unroll
                for (int kt = 0; kt < 4; ++kt) sa[4 + kt] = mfma32(kb[kt], qa[i], sa[4 + kt]);
                __builtin_amdgcn_sched_barrier(0); }
#pragma unroll
            for (int i = 0; i < 4; ++i) qa[i] = qn[i]; }
        float mx = -3.0e38f;
#pragma unroll
        for (int kt = 0; kt < 8; ++kt)
#pragma unroll
            for (int r = 0; r < 16; ++r) mx = fmaxf(mx, sa[kt][r]);
        mx = fmaxf(mx, __shfl_xor(mx, 32));
        float sum = 0.f; unsigned pf[8][2][4];
#pragma unroll
        for (int kt = 0; kt < 8; ++kt) {
#pragma unroll
            for (int r = 0; r < 16; ++r) { sa[kt][r] = __builtin_amdgcn_exp2f(sa[kt][r] - mx); sum += sa[kt][r]; }
#pragma unroll
            for (int s = 0; s < 2; ++s)
#pragma unroll
                for (int j = 0; j < 4; ++j) pf[kt][s][j] = cvtpk(sa[kt][8 * s + 2 * j], sa[kt][8 * s + 2 * j + 1]); }
        sum += __shfl_xor(sum, 32);
        const float inv = __builtin_amdgcn_rcpf(sum);
        __syncthreads();
        att_stage<8, true>(VTl + ((size_t)b * 1024 + hd * 256) * 256, 256, img, tid);
        __syncthreads();
        f32x16 oa[8];
#pragma unroll
        for (int vt = 0; vt < 8; ++vt) oa[vt] = zero16();
        const LAS bf16* vbase = img + r32 * ATT_LD + 8 * hf;
        bf16x8 va[4], vb[4];
#pragma unroll
        for (int vt = 0; vt < 4; ++vt) va[vt] = *(const LAS bf16x8*)(vbase + vt * 32 * ATT_LD);
#pragma unroll
        for (int st = 0; st < 16; ++st) { const int kt = st >> 1, s = st & 1, sn = (st + 1) & 15;
            u32x4 pa; pa.x = pf[kt][s][0]; pa.y = pf[kt][s][1]; pa.z = pf[kt][s][2]; pa.w = pf[kt][s][3];
            const bf16x8 a = __builtin_bit_cast(bf16x8, pa);
#pragma unroll
            for (int vt = 0; vt < 4; ++vt) vb[vt] = *(const LAS bf16x8*)(vbase + (4 + vt) * 32 * ATT_LD + st * 16);
            __builtin_amdgcn_sched_barrier(0);
#pragma unroll
            for (int vt = 0; vt < 4; ++vt) oa[vt] = mfma32(a, va[vt], oa[vt]);
            __builtin_amdgcn_sched_barrier(0);
#pragma unroll
            for (int vt = 0; vt < 4; ++vt) va[vt] = *(const LAS bf16x8*)(vbase + vt * 32 * ATT_LD + sn * 16);
            __builtin_amdgcn_sched_barrier(0);
#pragma unroll
            for (int vt = 0; vt < 4; ++vt) oa[4 + vt] = mfma32(a, vb[vt], oa[4 + vt]);
            __builtin_amdgcn_sched_barrier(0); }
        bf16* ob = O + m0 * D + hd * 256;
#pragma unroll
        for (int r = 0; r < 16; ++r) { const int i0 = crow(r, hf); const float sc = __shfl(inv, i0);
#pragma unroll
            for (int a = 0; a < 4; ++a) *(unsigned*)(ob + (size_t)i0 * D + 64 * a + 2 * r32) = cvtpk(oa[2 * a][r] * sc, oa[2 * a + 1][r] * sc); }
        __syncthreads();
    }
}
DI void final_phase(const Args& args, int gw, int ngw, int lane) {
    const float* part = (const float*)(args.ws + WS_PART); const f32x4* g = (const f32x4*)argp(args, I_GFINAL); float* out = args.out; const bf16* xb = (const bf16*)(args.ws + WS_XB);
    f32x4 gg[4];
#pragma unroll
    for (int j = 0; j < 4; ++j) gg[j] = g[lane + 64 * j];
    for (int m = gw; m < M; m += 4 * ngw) { uint2 v[4][4]; f32x4 pp[4][4];
#pragma unroll
        for (int r = 0; r < 4; ++r) { const int mm = (m + r * ngw < M) ? m + r * ngw : m; const uint2* xr = (const uint2*)(xb + (size_t)mm * D); const f32x4* pr = (const f32x4*)(part + (size_t)mm * 16);
#pragma unroll
            for (int j = 0; j < 4; ++j) { v[r][j] = xr[lane + 64 * j]; pp[r][j] = pr[j]; } }
#pragma unroll
        for (int r = 0; r < 4; ++r) { const int mm = m + r * ngw; if (mm < M) { f32x4* orow = (f32x4*)(out + (size_t)mm * D);
            const f32x4 a = pp[r][0], b = pp[r][1], c = pp[r][2], d = pp[r][3];
            const float rr = rsqrtf((((a.x + a.y) + (a.z + a.w)) + ((b.x + b.y) + (b.z + b.w)) + ((c.x + c.y) + (c.z + c.w)) + ((d.x + d.y) + (d.z + d.w))) * (1.f / D) + EPS);
#pragma unroll
            for (int j = 0; j < 4; ++j) { const f32x4 x = {blo(v[r][j].x), bhi(v[r][j].x), blo(v[r][j].y), bhi(v[r][j].y)}; orow[lane + 64 * j] = x * rr * gg[j]; } } } }
}
#ifndef PROBE
#define PROBE 0
#endif
#define IN(k) (lo <= (k) && (k) < hi)
#if defined(WAITPROBE) && WAITPROBE
#define SEAM(k) do { if (hi > (k) + 1) { const unsigned long long w0_ = __builtin_amdgcn_s_memrealtime(); xcd_barrier(bar); if ((WAITSEL >> (((k) >= PH_L0) ? (((k) - PH_L0) % PH_PER_LAYER) : 13 + (k))) & 1) *wacc += __builtin_amdgcn_s_memrealtime() - w0_; } } while (0)
#else
#define SEAM(k) do { if (hi > (k) + 1) { xcd_barrier(bar); if (PROBE & 512) xcd_barrier(bar); } } while (0)
#endif
#define SEAMG(k) do { if (hi > (k) + 1) grp_barrier(bar); } while (0)
#define SEAML(k) do { if (hi > (k) + 1) loc_barrier(bar); } while (0)
#define WSP(T, off) ((T*)(ws + (off)))
#define PHASE_IDS() int tid = wave * 64 + lane_id(); asm volatile("" : "+v"(tid)); int lane = tid & 63
constexpr int RSTD_OFF = RING_BYTES, RSTD_SLOTS = (MISC_OFF - RING_BYTES) / 1024;
DI bool slot_pm(const pg8::StaticOrder& S, int slot, int& pm) {
    if (S.G == 256 && S.nM == 128) { const int j = S.c >> 3, t = 32 * slot + j; pm = 16 * (S.c & 7) + (j & 7) + ((t >= 8 * S.nN) ? 8 : 0); return t < 16 * S.nN; }
    pg8::Unit u; const bool ok = S.next(slot, u); pm = u.pm; return ok;
}
DI pg8::RstdTab rstd_table(const pg8::StaticOrder& S, const float* part, LAS unsigned char* lds, int tid) {
    pg8::RstdTab rt; rt.tab = (const LAS float*)(lds + RSTD_OFF);
    LAS float* tab = (LAS float*)(lds + RSTD_OFF);
    constexpr int NE = RSTD_SLOTS * 256 / NTHR;
#pragma unroll
    for (int b0 = 0; b0 < NE; b0 += 6) { f32x4 pv[6][4]; bool ok[6];
        { pg8::Unit u0; if (b0 > 0 && !S.next(b0 * 2, u0)) break; }
#pragma unroll
        for (int k = 0; k < 6; ++k) { const int e = tid + NTHR * (b0 + k); int pm; ok[k] = slot_pm(S, e >> 8, pm); const f32x4* p = (const f32x4*)(part + ((size_t)(ok[k] ? pm : 0) * 256 + (e & 255)) * 16);
#pragma unroll
            for (int q = 0; q < 4; ++q) pv[k][q] = p[q]; }
#pragma unroll
        for (int k = 0; k < 6; ++k) { const int e = tid + NTHR * (b0 + k); const f32x4 a = pv[k][0], b = pv[k][1], c = pv[k][2], d = pv[k][3];
            const float s = ((a.x + a.y) + (a.z + a.w)) + ((b.x + b.y) + (b.z + b.w)) + ((c.x + c.y) + (c.z + c.w)) + ((d.x + d.y) + (d.z + d.w));
            if (ok[k]) tab[e] = rsqrtf(s * (1.f / D) + EPS); } }
    __syncthreads();
    return rt;
}
#define GEMM_SITE_RT(EpiT, gexpr, ...) do { pg8::Gemm g = gexpr; pg8::StaticOrder S; S.init(g.M, g.N, G, (int)blockIdx.x); int tid_rt = wave * 64 + lane_id(); asm volatile("" : "+v"(tid_rt)); \
        const pg8::RstdTab rt = rstd_table(S, WSP(float, WS_PART), lds, tid_rt); pg8::EpiT E = pg8::EpiT{rt, __VA_ARGS__}; pg8::gemm_phase<pg8::EpiT, pg8::StaticOrder, true, true>(lds, g, S, E, wave); } while (0)
#define GEMM_SITE(EpiT, gexpr, eexpr) do { pg8::Gemm g = gexpr; pg8::StaticOrder S; S.init(g.M, g.N, G, (int)blockIdx.x); pg8::EpiT E = eexpr; pg8::gemm_phase<pg8::EpiT, pg8::StaticOrder, true, true>(lds, g, S, E, wave); } while (0)

template <int L>
DI void layer_phases(const Args& args, LAS unsigned char* lds, const XcdBarrier& bar, const int lo, const int hi, const int G, const int wave, unsigned long long* wacc) {
    unsigned char* const ws = args.ws;
    constexpr int l = L, base = PH_L0 + L * PH_PER_LAYER;
    const int gw = blockIdx.x * NWAVES + wave, ngw = G * NWAVES;
    unsigned char* const wlb = wl_base(args, l);
    if (IN(base + LP_GUA)) {
#if defined(CLKPROBE) && CLKPROBE == 2
        const unsigned long long gc0_ = __builtin_amdgcn_s_memtime(), gr0_ = __builtin_amdgcn_s_memrealtime();
#endif
        GEMM_SITE_RT(EpiSwiglu, (pg8::Gemm{WSP(bf16, WS_XB), (bf16*)(wlb + WL_GUA), M, 2 * DFF, D}), WSP(bf16, WS_H));
#if defined(CLKPROBE) && CLKPROBE == 2
        wacc[1] += __builtin_amdgcn_s_memtime() - gc0_; wacc[2] += __builtin_amdgcn_s_memrealtime() - gr0_;
#endif
        if (PROBE & 1) { xcd_barrier(bar);
        GEMM_SITE_RT(EpiSwiglu, (pg8::Gemm{WSP(bf16, WS_XB), (bf16*)(wlb + WL_GUA), M, 2 * DFF, D}), WSP(bf16, WS_H));
        }
        SEAMG(base + LP_GUA); }
    if (IN(base + LP_DNA)) {
        GEMM_SITE(EpiRes, (pg8::Gemm{WSP(bf16, WS_H), (bf16*)(wlb + WL_DNA), M, D, DFF}), (pg8::EpiRes{WSP(bf16, WS_XB), WSP(float, WS_PART), 0.5f}));
        if (PROBE & 32) { xcd_barrier(bar);
        GEMM_SITE(EpiRes, (pg8::Gemm{WSP(bf16, WS_H), (bf16*)(wlb + WL_DNA), M, D, DFF}), (pg8::EpiRes{WSP(bf16, WS_XB), WSP(float, WS_PART), 0.0f}));
        }
        SEAM(base + LP_DNA);      }
    if (IN(base + LP_WIN)) {
        GEMM_SITE_RT(EpiScale, (pg8::Gemm{WSP(bf16, WS_XB), (bf16*)(wlb + WL_IN), M, DINP, D}), WSP(bf16, WS_P), 0, 1.f);
        if (PROBE & 1) { xcd_barrier(bar);
        GEMM_SITE_RT(EpiScale, (pg8::Gemm{WSP(bf16, WS_XB), (bf16*)(wlb + WL_IN), M, DINP, D}), WSP(bf16, WS_P), 0, 1.f);
        }
        SEAM(base + LP_WIN); }
    if (IN(base + LP_MIXA) || IN(base + LP_SCAN) || IN(base + LP_MIXB)) {
        MixCtx cx; cx.ws = ws; cx.w_a2 = (const float*)argp(args, I_GLAWA2) + (size_t)l * 16 * 192; cx.b_a = (const float*)argp(args, I_GLABA) + l * 192; cx.gla_gn = (const float*)argp(args, I_GLAGN) + l * 384;
        cx.ret_gn = (const float*)argp(args, I_RETGN) + l * 384; cx.conv = (const float*)argp(args, I_MLCONV) + (size_t)l * 4 * 512; cx.b_i = (const float*)argp(args, I_MLBI) + l * 4; cx.b_f = (const float*)argp(args, I_MLBF) + l * 4;
        if (IN(base + LP_MIXA)) { PHASE_IDS(); mix_passA(cx, lds + wave * WSLICE, wave, G, lane); SEAM(base + LP_MIXA); }
        if (IN(base + LP_SCAN)) { PHASE_IDS(); mix_scan(cx, blockIdx.x * NTHR + tid, G * NTHR); if (l + 1 < DEPTH) convert_layer(args, l + 1, (LAS float*)(lds + wave * WSLICE), gw, ngw, lane); SEAM(base + LP_SCAN); }
        if (PROBE & 2) { { PHASE_IDS(); mix_passA(cx, lds + wave * WSLICE, wave, G, lane); } xcd_barrier(bar); { PHASE_IDS(); mix_scan(cx, blockIdx.x * NTHR + tid, G * NTHR); } xcd_barrier(bar); { PHASE_IDS(); mix_passB(cx, lds + wave * WSLICE, wave, G, lane); } xcd_barrier(bar); }
        if (IN(base + LP_MIXB)) { { PHASE_IDS(); mix_passB(cx, lds + wave * WSLICE, wave, G, lane); } if (PROBE & 16) { xcd_barrier(bar); PHASE_IDS(); mix_passB(cx, lds + wave * WSLICE, wave, G, lane); } SEAM(base + LP_MIXB); }
    }
    if (IN(base + LP_WOUT)) {
        GEMM_SITE(EpiRes, (pg8::Gemm{WSP(bf16, WS_Y), (bf16*)(wlb + WL_OUT), M, D, D}), (pg8::EpiRes{WSP(bf16, WS_XB), WSP(float, WS_PART), 1.0f}));
        if (PROBE & 32) { xcd_barrier(bar);
        GEMM_SITE(EpiRes, (pg8::Gemm{WSP(bf16, WS_Y), (bf16*)(wlb + WL_OUT), M, D, D}), (pg8::EpiRes{WSP(bf16, WS_XB), WSP(float, WS_PART), 0.0f}));
        }
        SEAMG(base + LP_WOUT); }
    if (IN(base + LP_XQ)) {
        GEMM_SITE_RT(EpiScale, (pg8::Gemm{WSP(bf16, WS_XB), (bf16*)(wlb + WL_XQ), M, D, D}), WSP(bf16, WS_Q), D, 0.0625f * 1.4426950408889634f);
        if (PROBE & 1) { xcd_barrier(bar);
        GEMM_SITE_RT(EpiScale, (pg8::Gemm{WSP(bf16, WS_XB), (bf16*)(wlb + WL_XQ), M, D, D}), WSP(bf16, WS_Q), D, 0.0625f * 1.4426950408889634f);
        }
        SEAML(base + LP_XQ);     }
    if (IN(base + LP_ATT)) { PHASE_IDS(); (void)lane; attn_phase(ws, l, lds, G, tid, wave); if (PROBE & 4) { xcd_barrier(bar); attn_phase(ws, l, lds, G, tid, wave); } SEAMG(base + LP_ATT); }
    if (IN(base + LP_XO)) {
        GEMM_SITE(EpiRes, (pg8::Gemm{WSP(bf16, WS_O), (bf16*)(wlb + WL_XO), M, D, D}), (pg8::EpiRes{WSP(bf16, WS_XB), WSP(float, WS_PART), 1.0f}));
        if (PROBE & 32) { xcd_barrier(bar);
        GEMM_SITE(EpiRes, (pg8::Gemm{WSP(bf16, WS_O), (bf16*)(wlb + WL_XO), M, D, D}), (pg8::EpiRes{WSP(bf16, WS_XB), WSP(float, WS_PART), 0.0f}));
        }
        SEAMG(base + LP_XO); }
    if (IN(base + LP_GUB)) {
        GEMM_SITE_RT(EpiSwiglu, (pg8::Gemm{WSP(bf16, WS_XB), (bf16*)(wlb + WL_GUB), M, 2 * DFF, D}), WSP(bf16, WS_H));
        if (PROBE & 1) { xcd_barrier(bar);
        GEMM_SITE_RT(EpiSwiglu, (pg8::Gemm{WSP(bf16, WS_XB), (bf16*)(wlb + WL_GUB), M, 2 * DFF, D}), WSP(bf16, WS_H));
        }
        SEAMG(base + LP_GUB); }
    if (IN(base + LP_DNB)) {
        GEMM_SITE(EpiRes, (pg8::Gemm{WSP(bf16, WS_H), (bf16*)(wlb + WL_DNB), M, D, DFF}), (pg8::EpiRes{WSP(bf16, WS_XB), WSP(float, WS_PART), 0.5f}));
        if (PROBE & 32) { xcd_barrier(bar);
        GEMM_SITE(EpiRes, (pg8::Gemm{WSP(bf16, WS_H), (bf16*)(wlb + WL_DNB), M, D, DFF}), (pg8::EpiRes{WSP(bf16, WS_XB), WSP(float, WS_PART), 0.0f}));
        }
        if (L + 1 < DEPTH) SEAMG(base + LP_DNB); else SEAM(base + LP_DNB); }
}

__global__ void __launch_bounds__(NTHR, 2) fwd(Args args) {
    extern __shared__ __attribute__((aligned(16))) unsigned char lds_raw[];
    LAS unsigned char* lds = (LAS unsigned char*)lds_raw;
    const int wave = __builtin_amdgcn_readfirstlane((int)threadIdx.x >> 6);
    const int G = gridDim.x;
    unsigned char* const ws = args.ws;
    for (int u = wave * 64 + lane_id(); u < (LDS_BYTES - MISC_OFF) / 4; u += NTHR) ((LAS unsigned*)(lds + MISC_OFF))[u] = 0u;
    __syncthreads();
    const XcdBarrier bar = xcd_barrier_post((unsigned*)(ws + WS_CTL) + CW_BAR + args.li * XCD_BAR_WORDS, (volatile LAS unsigned*)(lds + MISC_OFF), wave);
    grp_post(bar);
    const int lo = args.ph_lo, hi = args.ph_hi;
    unsigned long long wacc_a[3] = {0ull, 0ull, 0ull}; unsigned long long* wacc = wacc_a; unsigned long long& wacc_v = wacc_a[0];
#if defined(CLKPROBE) && CLKPROBE
    const unsigned long long clk_c0 = __builtin_amdgcn_s_memtime(), clk_r0 = __builtin_amdgcn_s_memrealtime();
#endif

    if (IN(PH_PRO)) { PHASE_IDS();
        const int gw = blockIdx.x * NWAVES + wave, ngw = G * NWAVES; LAS float* scr = (LAS float*)(lds + wave * WSLICE);
        convert_kv(args, scr, gw, ngw, lane);
        convert_layer(args, 0, scr, gw, ngw, lane);
        stats_rows<4>((const float*)argp(args, I_X), WSP(bf16, WS_XB), WSP(float, WS_PART), gw, ngw, M, lane);
        stats_rows<1>((const float*)argp(args, I_MEM), WSP(bf16, WS_MEMB), WSP(float, WS_MEMP), gw, ngw, BATCH * MEMLEN, lane);
        { const int* pos = (const int*)argp(args, I_POS); float2* rope = WSP(float2, WS_ROPE);
          for (int i = blockIdx.x * NTHR + tid; i < M * 16; i += G * NTHR) { const int r = i >> 4, m = i & 15;
            const float invf = 1.0f / powf(10000.0f, (float)m / 15.0f); const float ang = (float)pos[r] * invf;
            double tr = (double)ang * 0.15915494309189535; tr -= __builtin_rint(tr);
            rope[i] = make_float2(__builtin_amdgcn_cosf((float)tr), __builtin_amdgcn_sinf((float)tr)); } }
        SEAM(PH_PRO); grp_decide(bar, G);
    }
    if (IN(PH_KV)) {
        GEMM_SITE(EpiKV, (pg8::Gemm{WSP(bf16, WS_MEMB), WSP(bf16, WS_WKV), BATCH * MEMLEN, DEPTH * 2048, D}), (pg8::EpiKV{WSP(float, WS_MEMP), WSP(bf16, WS_KB), WSP(bf16, WS_VT)}));
        SEAM(PH_KV);
    }
    layer_phases<0>(args, lds, bar, lo, hi, G, wave, wacc);
    layer_phases<1>(args, lds, bar, lo, hi, G, wave, wacc);
    layer_phases<2>(args, lds, bar, lo, hi, G, wave, wacc);
    layer_phases<3>(args, lds, bar, lo, hi, G, wave, wacc);
    if (IN(PH_FINAL)) { PHASE_IDS(); final_phase(args, blockIdx.x * NWAVES + wave, G * NWAVES, lane); }
#if defined(WAITPROBE) && WAITPROBE
#if WAITPROBE == 2000
    { unsigned* tb_ = (unsigned*)(ws + WS_CTL) + 4096;
      if (wave == 0 && lane_id() == 0) __hip_atomic_store(tb_ + blockIdx.x, 1u + xb_xcc_id(), __ATOMIC_RELAXED, __HIP_MEMORY_SCOPE_AGENT);
      xcd_barrier(bar);
      if (blockIdx.x == 0 && wave == 0) { unsigned mis = 0; for (int b_ = 0; b_ < G; ++b_) mis += __hip_atomic_load(tb_ + b_, __ATOMIC_RELAXED, __HIP_MEMORY_SCOPE_AGENT) != __hip_atomic_load(tb_ + (b_ & 7), __ATOMIC_RELAXED, __HIP_MEMORY_SCOPE_AGENT);
          const unsigned long long r1 = __builtin_amdgcn_s_memrealtime(); while (__builtin_amdgcn_s_memrealtime() - r1 < 10000ull + (unsigned long long)mis * 1000ull) __builtin_amdgcn_s_sleep(8); } }
#else
    if (blockIdx.x == WAITPROBE - 1 && wave == 0) { const unsigned long long r1 = __builtin_amdgcn_s_memrealtime(); while (__builtin_amdgcn_s_memrealtime() - r1 < wacc_v) __builtin_amdgcn_s_sleep(8); }
#endif
#endif
#if defined(CLKPROBE) && CLKPROBE
    if (blockIdx.x == 0 && wave == 0) { const unsigned long long r1 = __builtin_amdgcn_s_memrealtime(); const unsigned long long dc = (CLKPROBE == 2) ? wacc_a[1] : __builtin_amdgcn_s_memtime() - clk_c0, dr = (CLKPROBE == 2) ? wacc_a[2] : r1 - clk_r0;
        const unsigned long long mhz = dc * 100ull / (dr ? dr : 1ull); while (__builtin_amdgcn_s_memrealtime() - r1 < mhz * 50ull) __builtin_amdgcn_s_sleep(8); }
#endif
}
#undef IN
#undef SEAM
extern "C" void kernel_launch(void* const* d_in, const int* in_sizes, int n_in, void* d_out, int out_size, void* d_ws, size_t ws_size, hipStream_t stream) {
    static int grid = 0;
    if (grid == 0) {
        if (n_in != 25 || ws_size < WS_END || out_size != M * D) { fprintf(stderr, "kernel_launch: unexpected inputs (n_in %d, ws %zu, out %d)\n", n_in, ws_size, out_size); grid = -1; return; }
        int dev = 0, cus = 0, per_cu = 0;
        if (hipGetDevice(&dev) != hipSuccess || hipDeviceGetAttribute(&cus, hipDeviceAttributeMultiprocessorCount, dev) != hipSuccess) { grid = -1; return; }
        if (hipFuncSetAttribute((const void*)fwd, hipFuncAttributeMaxDynamicSharedMemorySize, LDS_BYTES) != hipSuccess) { fprintf(stderr, "kernel_launch: hipFuncSetAttribute failed\n"); grid = -1; return; }
        if (hipOccupancyMaxActiveBlocksPerMultiprocessor(&per_cu, (const void*)fwd, NTHR, LDS_BYTES) != hipSuccess || per_cu < 1) fprintf(stderr, "kernel_launch: occupancy query says %d\n", per_cu);
        (void)hipGetLastError();
        if (cus < 128) { fprintf(stderr, "kernel_launch: needs >= 128 CUs (rstd table slots)\n"); grid = -1; return; }
        grid = cus & ~7;
    }
    if (grid < 0) return;
    (void)hipMemsetAsync((char*)d_ws + WS_CTL, 0, CTL_ZERO_BYTES, stream);
    unsigned char* ws = (unsigned char*)d_ws; float* out = (float*)d_out;
    int li = 0;
    auto launch = [&](int lo, int hi) {
        Args a{}; for (int i = 0; i < 25; ++i) a.in[i] = d_in[i];
        a.out = out; a.ws = ws; a.ph_lo = lo; a.ph_hi = hi; a.li = li++; a.pad = 0;
        hipLaunchKernelGGL(fwd, dim3(grid), dim3(NTHR), LDS_BYTES, stream, a);
    };
    launch(PH_PRO, PH_END);
}
```
